# Optimizing an MI355X kernel written in HIP

```python
import jax, jax.numpy as jnp
from jax import lax
import numpy as np

D_MODEL = 2048
BATCH = 2
SEQ = 4096
DEPTH = 1

N_HEADS_MOBA = 8
HEAD_DIM_MOBA = 128
MOBA_BLOCK = 256
MOBA_TOPK = 3
MOBA_Q_CHUNK = 32
N_HEADS_RET = 8
HEAD_DIM_RET_QK = 128
HEAD_DIM_RET_V = 256
RET_CHUNK = 128
ROPE_BASE = 10000.0
N_GROUPS = 4
EXPERTS_PER_GROUP = 8
N_EXPERTS = N_GROUPS * EXPERTS_PER_GROUP
EXPERT_TOPK = 2
D_EXPERT = 512

RMS_EPS = 1e-6
GN_EPS = 1e-6
NEG_BIG = -1e30

W_MOBA = N_HEADS_MOBA * HEAD_DIM_MOBA
W_RET_QK = N_HEADS_RET * HEAD_DIM_RET_QK
W_RET_V = N_HEADS_RET * HEAD_DIM_RET_V
IN_SIZES = (W_MOBA, W_MOBA, W_MOBA, W_RET_QK, W_RET_QK, W_RET_V, W_RET_V, D_MODEL, D_MODEL)
N_IN = sum(IN_SIZES)

kernel_name = "hybrid_moba_retention_hmoe_block"


def rmsnorm(x, w):
    xf = x.astype(jnp.float32)
    xf = xf * lax.rsqrt(jnp.mean(xf * xf, axis=-1, keepdims=True) + RMS_EPS)
    return xf.astype(x.dtype) * w


def to_heads(t, n_heads):
    b, s, _ = t.shape
    return t.reshape(b, s, n_heads, -1).transpose(0, 2, 1, 3)


def moba_attention(q, k, v):
    B, H, S, hd = q.shape
    nb = -(-S // MOBA_BLOCK)
    pad = nb * MOBA_BLOCK - S
    kp = jnp.pad(k, ((0, 0), (0, 0), (0, pad), (0, 0)))
    vp = jnp.pad(v, ((0, 0), (0, 0), (0, pad), (0, 0)))
    kb = kp.reshape(B, H, nb, MOBA_BLOCK, hd)
    vb = vp.reshape(B, H, nb, MOBA_BLOCK, hd)
    scale = hd ** -0.5
    k_mean = jnp.mean(kb.astype(jnp.float32), axis=3)
    gate = jnp.einsum('bhsd,bhnd->bhsn', q.astype(jnp.float32), k_mean)
    q_block = jnp.arange(S) // MOBA_BLOCK
    past = jnp.arange(nb)[None, :] < q_block[:, None]
    gate = jnp.where(past, gate, -jnp.inf)
    n_sel = min(MOBA_TOPK, nb)
    _, sel = lax.top_k(gate, n_sel)
    valid = sel < q_block[None, None, :, None]

    nq = S // MOBA_Q_CHUNK
    qc = q.reshape(B, H, nq, MOBA_Q_CHUNK, hd).transpose(2, 0, 1, 3, 4)
    selc = sel.reshape(B, H, nq, MOBA_Q_CHUNK, n_sel).transpose(2, 0, 1, 3, 4)
    validc = valid.reshape(B, H, nq, MOBA_Q_CHUNK, n_sel).transpose(2, 0, 1, 3, 4)
    bi = jnp.arange(B)[:, None, None, None]
    hi = jnp.arange(H)[None, :, None, None]
    n_sel_keys = n_sel * MOBA_BLOCK

    def one_chunk(args):
        c, q_c, sel_c, valid_c = args
        start = c * MOBA_Q_CHUNK
        blk = start // MOBA_BLOCK
        q_pos = start + jnp.arange(MOBA_Q_CHUNK)
        k_sel = kb[bi, hi, sel_c]
        v_sel = vb[bi, hi, sel_c]
        s_sel = jnp.einsum('bhqd,bhqnkd->bhqnk', q_c, k_sel).astype(jnp.float32) * scale
        s_sel = jnp.where(valid_c[..., None], s_sel, NEG_BIG).reshape(B, H, MOBA_Q_CHUNK, n_sel_keys)
        k_own = lax.dynamic_slice_in_dim(kp, blk * MOBA_BLOCK, MOBA_BLOCK, axis=2)
        v_own = lax.dynamic_slice_in_dim(vp, blk * MOBA_BLOCK, MOBA_BLOCK, axis=2)
        s_own = jnp.einsum('bhqd,bhkd->bhqk', q_c, k_own).astype(jnp.float32) * scale
        k_pos = blk * MOBA_BLOCK + jnp.arange(MOBA_BLOCK)
        s_own = jnp.where(k_pos[None, :] <= q_pos[:, None], s_own, NEG_BIG)
        p = jax.nn.softmax(jnp.concatenate([s_sel, s_own], axis=-1), axis=-1)
        p_sel = p[..., :n_sel_keys].reshape(B, H, MOBA_Q_CHUNK, n_sel, MOBA_BLOCK)
        p_own = p[..., n_sel_keys:]
        out = (jnp.einsum('bhqnk,bhqnkd->bhqd', p_sel, v_sel.astype(jnp.float32))
               + jnp.einsum('bhqk,bhkd->bhqd', p_own, v_own.astype(jnp.float32)))
        return out.astype(q.dtype)

    out = lax.map(one_chunk, (jnp.arange(nq), qc, selc, validc))
    return out.transpose(1, 2, 0, 3, 4).reshape(B, H, S, hd)


def rotary(x, pos):
    half = x.shape[-1] // 2
    inv = ROPE_BASE ** (-jnp.arange(half, dtype=jnp.float32) / half)
    ang = pos.astype(jnp.float32)[:, None] * inv[None, :]
    cos, sin = jnp.cos(ang), jnp.sin(ang)
    x1 = x[..., :half].astype(jnp.float32)
    x2 = x[..., half:].astype(jnp.float32)
    return jnp.concatenate([x1 * cos - x2 * sin, x1 * sin + x2 * cos], axis=-1).astype(x.dtype)


def retention(q, k, v):
    B, H, S, dk = q.shape
    dv = v.shape[-1]
    C = RET_CHUNK
    nc = S // C
    log_gamma = jnp.log(1.0 - 2.0 ** (-5.0 - jnp.arange(H, dtype=jnp.float32)))
    idx = jnp.arange(C, dtype=jnp.float32)
    diff = idx[:, None] - idx[None, :]
    decay_in = jnp.where(diff >= 0, jnp.exp(log_gamma[:, None, None] * jnp.maximum(diff, 0.0)), 0.0)
    qc = q.astype(jnp.float32).reshape(B, H, nc, C, dk)
    kc = k.astype(jnp.float32).reshape(B, H, nc, C, dk)
    vc = v.astype(jnp.float32).reshape(B, H, nc, C, dv)
    scores = jnp.einsum('bhnid,bhnjd->bhnij', qc, kc) * decay_in[None, :, None]
    o_inner = jnp.einsum('bhnij,bhnjv->bhniv', scores, vc)
    zeta = jnp.exp(log_gamma[:, None] * (C - 1.0 - idx)[None, :])
    u = jnp.einsum('bhnjd,bhnjv->nbhdv', kc * zeta[None, :, None, :, None], vc)
    chunk_decay = jnp.exp(log_gamma * C)[None, :, None, None]

    def step(state, u_n):
        return chunk_decay * state + u_n, state

    _, r_prev = lax.scan(step, jnp.zeros((B, H, dk, dv), jnp.float32), u)
    xi = jnp.exp(log_gamma[:, None] * (idx + 1.0)[None, :])
    o_cross = jnp.einsum('bhnid,nbhdv->bhniv', qc * xi[None, :, None, :, None], r_prev)
    return (o_inner + o_cross).reshape(B, H, S, dv)


def head_group_norm(y):
    mu = jnp.mean(y, axis=-1, keepdims=True)
    var = jnp.mean(jnp.square(y - mu), axis=-1, keepdims=True)
    yn = (y - mu) * lax.rsqrt(var + GN_EPS)
    B, H, S, dv = y.shape
    return yn.transpose(0, 2, 1, 3).reshape(B, S, H * dv)


def hierarchical_moe(h, w_rg, b_rg, w_re, b_re, w_gate, w_up, w_down):
    hf = h.astype(jnp.float32)
    g_logits = hf @ w_rg.astype(jnp.float32) + b_rg.astype(jnp.float32)
    g_prob = jax.nn.softmax(g_logits, axis=-1)
    g_onehot = jax.nn.one_hot(jnp.argmax(g_logits, axis=-1), N_GROUPS, dtype=jnp.float32)
    g_weight = jnp.sum(g_prob * g_onehot, axis=-1, keepdims=True)
    e_logits_all = jnp.einsum('td,gde->tge', hf, w_re.astype(jnp.float32)) + b_re.astype(jnp.float32)
    e_logits = jnp.einsum('tge,tg->te', e_logits_all, g_onehot)
    e_prob = jax.nn.softmax(e_logits, axis=-1)
    top_p, top_i = lax.top_k(e_prob, EXPERT_TOPK)
    top_p = top_p / jnp.sum(top_p, axis=-1, keepdims=True)
    within = jnp.sum(jax.nn.one_hot(top_i, EXPERTS_PER_GROUP, dtype=jnp.float32) * top_p[..., None], axis=1)
    comb = ((g_weight * g_onehot)[:, :, None] * within[:, None, :]).reshape(h.shape[0], N_EXPERTS).astype(h.dtype)
    y = jnp.zeros_like(h)
    for e in range(N_EXPERTS):
        act = jax.nn.silu(h @ w_gate[e]) * (h @ w_up[e])
        y = y + comb[:, e:e + 1] * (act @ w_down[e])
    return y


def setup_inputs(seed: int = 0) -> dict:
    key = jax.random.key(seed)
    ks = jax.random.split(key, 16)
    f = jnp.float32
    n = jax.random.normal
    return {
        "x": n(ks[0], (BATCH, SEQ, D_MODEL), f),
        "norm_mix_w": 1.0 + 0.05 * n(ks[1], (DEPTH, D_MODEL), f),
        "w_in": n(ks[2], (DEPTH, D_MODEL, N_IN), f) * D_MODEL ** -0.5,
        "ret_gn_w": 1.0 + 0.05 * n(ks[3], (DEPTH, W_RET_V), f),
        "w_branch_moba": n(ks[4], (DEPTH, W_MOBA, D_MODEL), f) * W_MOBA ** -0.5,
        "w_branch_ret": n(ks[5], (DEPTH, W_RET_V, D_MODEL), f) * W_RET_V ** -0.5,
        "w_out": n(ks[6], (DEPTH, D_MODEL, D_MODEL), f) * D_MODEL ** -0.5,
        "norm_ffn_w": 1.0 + 0.05 * n(ks[7], (DEPTH, D_MODEL), f),
        "w_router_group": n(ks[8], (DEPTH, D_MODEL, N_GROUPS), f) * D_MODEL ** -0.5,
        "b_router_group": 0.01 * n(ks[9], (DEPTH, N_GROUPS), f),
        "w_router_expert": n(ks[10], (DEPTH, N_GROUPS, D_MODEL, EXPERTS_PER_GROUP), f) * D_MODEL ** -0.5,
        "b_router_expert": 0.01 * n(ks[11], (DEPTH, N_GROUPS, EXPERTS_PER_GROUP), f),
        "w_expert_gate": n(ks[12], (DEPTH, N_EXPERTS, D_MODEL, D_EXPERT), f) * D_MODEL ** -0.5,
        "w_expert_up": n(ks[13], (DEPTH, N_EXPERTS, D_MODEL, D_EXPERT), f) * D_MODEL ** -0.5,
        "w_expert_down": n(ks[14], (DEPTH, N_EXPERTS, D_EXPERT, D_MODEL), f) * D_EXPERT ** -0.5,
        "norm_final_w": 1.0 + 0.05 * n(ks[15], (D_MODEL,), f),
    }


def reference(x, norm_mix_w, w_in, ret_gn_w, w_branch_moba, w_branch_ret, w_out, norm_ffn_w,
              w_router_group, b_router_group, w_router_expert, b_router_expert,
              w_expert_gate, w_expert_up, w_expert_down, norm_final_w):
    B, S, D = x.shape
    pos = jnp.arange(S)
    split_points = np.cumsum(IN_SIZES)[:-1].tolist()
    for l in range(DEPTH):
        h = rmsnorm(x, norm_mix_w[l])
        proj = h @ w_in[l]
        mq, mk, mv, rq, rk, rv, rg, ga, gr = jnp.split(proj, split_points, axis=-1)
        o_a = moba_attention(to_heads(mq, N_HEADS_MOBA), to_heads(mk, N_HEADS_MOBA), to_heads(mv, N_HEADS_MOBA))
        o_a = o_a.transpose(0, 2, 1, 3).reshape(B, S, W_MOBA)
        q_r = rotary(to_heads(rq, N_HEADS_RET), pos)
        k_r = rotary(to_heads(rk, N_HEADS_RET), pos) * (HEAD_DIM_RET_QK ** -0.5)
        y_r = retention(q_r, k_r, to_heads(rv, N_HEADS_RET))
        y_r = head_group_norm(y_r).astype(x.dtype) * ret_gn_w[l]
        y_r = jax.nn.silu(rg) * y_r
        mix = jax.nn.sigmoid(ga) * (o_a @ w_branch_moba[l]) + jax.nn.sigmoid(gr) * (y_r @ w_branch_ret[l])
        x = x + mix @ w_out[l]
        h = rmsnorm(x, norm_ffn_w[l]).reshape(B * S, D)
        y = hierarchical_moe(h, w_router_group[l], b_router_group[l], w_router_expert[l], b_router_expert[l],
                             w_expert_gate[l], w_expert_up[l], w_expert_down[l])
        x = x + y.reshape(B, S, D)
    return rmsnorm(x, norm_final_w)
```

```cpp
#include <hip/hip_runtime.h>
#include <hip/hip_cooperative_groups.h>
#include <cstdio>
#include <cstdint>
namespace cg = cooperative_groups;

#ifndef MK_MULTI
#define MK_MULTI 0
#endif

#define GAS __attribute__((address_space(1)))
#define LAS __attribute__((address_space(3)))
typedef unsigned short bf16;
typedef unsigned u32x4 __attribute__((ext_vector_type(4)));
typedef unsigned u32x2 __attribute__((ext_vector_type(2)));
typedef float f32x4 __attribute__((ext_vector_type(4)));
typedef short bf16x8 __attribute__((ext_vector_type(8)));
typedef float f32x16 __attribute__((ext_vector_type(16)));

constexpr int T = 8192, DM = 2048, SEQ = 4096, NBATCH = 2, NIN = 13312, NHEAD = 8;
constexpr int NEXP = 32, DEXP = 512;
constexpr float RMS_EPS = 1e-6f, GN_EPS = 1e-6f;
constexpr int XG_ROWS = 24576;

constexpr size_t MiB = 1u << 20;
constexpr size_t WS_CTL = 0, CTL_ZERO_BYTES = 1 * MiB;
constexpr size_t OFF_KMEAN = 64 * 1024;
constexpr size_t WS_KMEAN1 = 5 * MiB + 512 * 1024;
constexpr size_t OFF_SSQ = 192 * 1024;
constexpr size_t OFF_CNT = 224 * 1024;
constexpr size_t WS_COS = 1 * MiB, WS_SIN = 2 * MiB;
constexpr size_t WS_WRT = 3 * MiB;
constexpr size_t WS_RSTD = 3 * MiB + 256 * 1024;
constexpr size_t WS_LISTTOK = 3 * MiB + 512 * 1024;
constexpr size_t WS_LISTW = 4 * MiB + 512 * 1024;
constexpr size_t WS_HS = 5 * MiB + 768 * 1024;
constexpr size_t WS_DLT = 6 * MiB, WS_DLW = 7 * MiB;
constexpr size_t WS_ROWTOK = 5 * MiB + 512 * 1024;
constexpr size_t WS_ROWW = WS_ROWTOK + 96 * 1024;
constexpr size_t WS_ROWRS = WS_ROWW + 96 * 1024;
constexpr size_t WS_W1T = 8 * MiB;
constexpr size_t WS_W2T = 136 * MiB;
constexpr size_t WS_WMT = 200 * MiB, WS_WRT2 = 204 * MiB, WS_WOT = 212 * MiB;
constexpr size_t WS_WINT = 220 * MiB;
constexpr size_t WS_WIN8 = 244 * MiB;
constexpr size_t WS_HB8 = 512 * MiB;
constexpr size_t WS_HB = 272 * MiB;
constexpr size_t WS_MQ = 304 * MiB, WS_MK = 320 * MiB, WS_MV = 336 * MiB, WS_RQ = 352 * MiB, WS_RK = 368 * MiB;
constexpr size_t WS_RVT = 384 * MiB;
constexpr size_t WS_RG = 416 * MiB, WS_GA = 448 * MiB, WS_GR = 480 * MiB;
constexpr size_t WS_OA = 220 * MiB;
constexpr size_t WS_YR = 236 * MiB;
constexpr size_t WS_MIXA = 272 * MiB;
constexpr size_t WS_MIX = 304 * MiB;
constexpr size_t WS_X1 = 336 * MiB;
constexpr size_t WS_X1B = 400 * MiB;
constexpr size_t WS_XG = 220 * MiB;
constexpr size_t WS_ACT = 432 * MiB;
constexpr size_t WS_X1B8 = 512 * MiB;
constexpr size_t WS_Y = 220 * MiB;
constexpr size_t WS_SSQP = 448 * MiB;
constexpr size_t WS_END = 528 * MiB;

constexpr int RING_BYTES = 131072;
constexpr int MISC_OFF = RING_BYTES;
constexpr int LDS_BYTES = 147456;

__device__ __forceinline__ float bf_lo(unsigned u) { return __uint_as_float(u << 16); }
__device__ __forceinline__ float bf_hi(unsigned u) { return __uint_as_float(u & 0xffff0000u); }
__device__ __forceinline__ float bf2f(bf16 b) { return __uint_as_float(((unsigned)b) << 16); }
__device__ __forceinline__ unsigned f2bf(float f) { unsigned u = __float_as_uint(f); return (u + 0x7fffu + ((u >> 16) & 1u)) >> 16; }
typedef float f32x2_t __attribute__((ext_vector_type(2))); typedef __bf16 bf16x2_t __attribute__((ext_vector_type(2)));
__device__ __forceinline__ unsigned pk2(float lo, float hi) { f32x2_t v = {lo, hi}; bf16x2_t b = __builtin_convertvector(v, bf16x2_t); return __builtin_bit_cast(unsigned, b); }
__device__ __forceinline__ unsigned pk4_fp8(float a, float b, float c, float d) { int w = 0; w = __builtin_amdgcn_cvt_pk_fp8_f32(a, b, w, false); w = __builtin_amdgcn_cvt_pk_fp8_f32(c, d, w, true); return (unsigned)w; }
__device__ __forceinline__ f32x4 unpk4_fp8(unsigned w) { typedef float f2_ __attribute__((ext_vector_type(2))); const f2_ lo = __builtin_amdgcn_cvt_pk_f32_fp8((int)w, false), hi = __builtin_amdgcn_cvt_pk_f32_fp8((int)w, true); return (f32x4){lo.x, lo.y, hi.x, hi.y}; }
__device__ __forceinline__ unsigned pk4_i8(float a, float b, float c, float d) {
    const int ia = (int)__builtin_rintf(a), ib = (int)__builtin_rintf(b), ic = (int)__builtin_rintf(c), id = (int)__builtin_rintf(d);
    return ((unsigned)ia & 255u) | (((unsigned)ib & 255u) << 8) | (((unsigned)ic & 255u) << 16) | ((unsigned)id << 24);
}
__device__ __forceinline__ f32x4 i2f4(f32x4 v) { typedef int i4_ __attribute__((ext_vector_type(4))); const i4_ i = __builtin_bit_cast(i4_, v); return (f32x4){(float)i.x, (float)i.y, (float)i.z, (float)i.w}; }
__device__ __forceinline__ u32x4 pack8(f32x4 a, f32x4 b) { u32x4 w; w.x = pk2(a.x, a.y); w.y = pk2(a.z, a.w); w.z = pk2(b.x, b.y); w.w = pk2(b.z, b.w); return w; }
__device__ __forceinline__ float wave_sum(float v) {
#pragma unroll
    for (int o = 1; o < 64; o <<= 1) v += __shfl_xor(v, o);
    return v;
}
__device__ __forceinline__ float wave_max(float v) {
#pragma unroll
    for (int o = 1; o < 64; o <<= 1) v = fmaxf(v, __shfl_xor(v, o));
    return v;
}
__device__ __forceinline__ float sigmoidf_(float v) { return __builtin_amdgcn_rcpf(1.0f + __builtin_amdgcn_exp2f(v * -1.4426950408889634f)); }
__device__ __forceinline__ float siluf_(float v) { return v * __builtin_amdgcn_rcpf(1.0f + __builtin_amdgcn_exp2f(v * -1.4426950408889634f)); }
__device__ __forceinline__ int fresh_tid() { int t = threadIdx.x; asm volatile("" : "+v"(t)); return t; }
#define LDS_WAIT() asm volatile("s_waitcnt lgkmcnt(0)" ::: "memory")
#define VM_WAIT() asm volatile("s_waitcnt vmcnt(0)" ::: "memory")

__device__ __forceinline__ void st16_wt(unsigned char* ws, const void* p, u32x4 v) {
    const __amdgpu_buffer_rsrc_t r = __builtin_amdgcn_make_buffer_rsrc(ws, 0, 0x7ffff000, 0x00020000);
    __builtin_amdgcn_raw_buffer_store_b128(v, r, (int)(unsigned)((const unsigned char*)p - ws), 0, 16);
}
namespace pg8 {
#define PG8_LAS __attribute__((address_space(3)))
typedef unsigned short bf16_t;
constexpr int BM = 256, BK = 64, HALF = 128, HTB = HALF * BK * 2, STAGE_BYTES = 8 * HTB, NXCD = 8, WGM = 8;

__host__ __device__ __forceinline__ int lds_byte(int r, int c) { const int st = (r >> 4) * 2 + (c >> 5), rr = r & 15, cc = c & 31, ob = rr * 64 + cc * 2; return st * 1024 + (ob ^ (((ob >> 9) & 1) << 5)); }
__host__ __device__ __forceinline__ void stage_rc(int b, int& R, int& C) { const int st = b / 1024, sb = b % 1024, swz = sb ^ (((sb >> 9) & 1) << 5); R = (st >> 1) * 16 + swz / 64; C = (st & 1) * 32 + (swz % 64) / 2; }
__host__ __device__ __forceinline__ int perm32(int rho) { const int n = rho >> 4, i = rho & 15; return 8 * (i >> 2) + 4 * n + (i & 3); }

struct Unit { int pm, pn, kind, aux, slot, lite, half; };

__device__ __forceinline__ void tile_of(int L, int nM, int nN, int& pm, int& pn) {
    const int nwg = nM * nN;
    int wgid = L; { const int q = nwg / NXCD, r = nwg % NXCD, xcd = wgid % NXCD, off = wgid / NXCD; wgid = (xcd < r ? xcd * (q + 1) : r * (q + 1) + (xcd - r) * q) + off; }
    const int nig = WGM * nN, gid = wgid / nig, fm = gid * WGM, gsz = (nM - fm) < WGM ? (nM - fm) : WGM;
    pm = fm + ((wgid % nig) % gsz); pn = (wgid % nig) / gsz;
}

template <bool FP8, bool CP, bool I8, class Epi, class Sched>
__device__ __forceinline__ void gemm_phase(PG8_LAS unsigned char* lds, unsigned char* wsbase, const int K, const Sched& S, const Epi& E) {
    const __amdgpu_buffer_rsrc_t rsrc = __builtin_amdgcn_make_buffer_rsrc(wsbase, 0, 0x7ffff000, 0x00020000);
    const int tid = fresh_tid(), wid = __builtin_amdgcn_readfirstlane(tid >> 6), lane = tid & 63, wr = wid >> 2, wc = wid & 3, fr = lane & 15, fq = lane >> 4;
    const int nt = K / BK;
    unsigned voffA[2], voffB[2];
    int gR[2]; unsigned gC[2];
#pragma unroll
    for (int i = 0; i < 2; ++i) { int R, C; stage_rc(tid * 16 + i * 8192, R, C); const int Rb = ((R & ~31) + perm32(R & 31));
        const int l5 = perm32(R & 31), Rc = CP ? 64 * (R >> 5) + 16 * (l5 >> 3) + (l5 & 7) : Rb;
        voffA[i] = (unsigned)(R * K + C) * 2u; voffB[i] = (unsigned)(Rc * K + C) * 2u; gR[i] = R; gC[i] = (unsigned)C * 2u; }
    const unsigned kstep = (unsigned)(BK * 2);
    const unsigned hstep = (unsigned)(HALF * K * 2);
    const unsigned hstepB = CP ? (unsigned)(8 * K * 2) : hstep;
    unsigned ldsw = (unsigned)wid * 1024u;
    const int aoff = lds_byte(wr * 64 + fr, fq * 8), boff = lds_byte(wc * 32 + fr, fq * 8);
#define PG8_SA(b, h) (((b) * 2 + (h)) * HTB)
#define PG8_SB(b, h) ((4 + (b) * 2 + (h)) * HTB)
#define PG8_STAGE(bufoff, gbase, voff) do { _Pragma("unroll") for (int _i = 0; _i < 2; ++_i) \
        __builtin_amdgcn_raw_ptr_buffer_load_lds(rsrc, (PG8_LAS unsigned*)(lds + (bufoff) + ldsw + _i * 8192), 16, (int)(voff)[_i], (int)(gbase), 0, 0); } while (0)
#define PG8_STAGE_A(bufoff, gbase, half, isnext) do { if constexpr (Sched::GATHER) { unsigned vo_[2]; const int sl_ = (isnext) ? nslot : cur.slot; \
            _Pragma("unroll") for (int i_ = 0; i_ < 2; ++i_) vo_[i_] = (unsigned)S.arow(sl_, gR[i_] + 128 * (half)) * (unsigned)(2 * K) + gC[i_]; PG8_STAGE(bufoff, gbase, vo_); } \
        else PG8_STAGE(bufoff, (gbase) + (half) * hstep, voffA); } while (0)
#define PG8_LDA(dst, b, h) do { if constexpr (FP8) { _Pragma("unroll") for (int m = 0; m < 4; ++m) dst##8[m] = __builtin_shufflevector(*(const PG8_LAS i32x4_*)(lds + PG8_SA(b, h) + aoff + m * 2048), *(const PG8_LAS i32x4_*)(lds + PG8_SA(b, h) + aoff + m * 2048 + 1024), 0, 1, 2, 3, 4, 5, 6, 7); } \
        else { _Pragma("unroll") for (int m = 0; m < 4; ++m) _Pragma("unroll") for (int k = 0; k < 2; ++k) dst[m][k] = *(const PG8_LAS bf16x8*)(lds + PG8_SA(b, h) + aoff + m * 2048 + k * 1024); } } while (0)
#define PG8_LDB(dst, b, h) do { if constexpr (FP8) { _Pragma("unroll") for (int n = 0; n < 2; ++n) dst##8[n] = __builtin_shufflevector(*(const PG8_LAS i32x4_*)(lds + PG8_SB(b, h) + boff + n * 2048), *(const PG8_LAS i32x4_*)(lds + PG8_SB(b, h) + boff + n * 2048 + 1024), 0, 1, 2, 3, 4, 5, 6, 7); } \
        else { _Pragma("unroll") for (int n = 0; n < 2; ++n) _Pragma("unroll") for (int k = 0; k < 2; ++k) dst[n][k] = *(const PG8_LAS bf16x8*)(lds + PG8_SB(b, h) + boff + n * 2048 + k * 1024); } } while (0)
#define PG8_MMA(ai, bj, At, Bt) do { __builtin_amdgcn_s_setprio(1); _Pragma("unroll") for (int m = 0; m < 4; ++m) _Pragma("unroll") for (int n = 0; n < 2; ++n) { \
        if constexpr (FP8)   \
            { if constexpr (I8) {   \
                i32x4_ c_ = __builtin_bit_cast(i32x4_, acc[ai][bj][m][n]); \
                c_ = __builtin_amdgcn_mfma_i32_16x16x64_i8(__builtin_shufflevector(Bt##8[n], Bt##8[n], 0, 1, 2, 3), __builtin_shufflevector(At##8[m], At##8[m], 0, 1, 2, 3), c_, 0, 0, 0); \
                c_ = __builtin_amdgcn_mfma_i32_16x16x64_i8(__builtin_shufflevector(Bt##8[n], Bt##8[n], 4, 5, 6, 7), __builtin_shufflevector(At##8[m], At##8[m], 4, 5, 6, 7), c_, 0, 0, 0); \
                acc[ai][bj][m][n] = __builtin_bit_cast(f32x4, c_); } \
              else acc[ai][bj][m][n] = __builtin_amdgcn_mfma_scale_f32_16x16x128_f8f6f4(Bt##8[n], At##8[m], acc[ai][bj][m][n], 0, 0, 0, 0x7F7F7F7F, 0, 0x7F7F7F7F); } \
        else { _Pragma("unroll") for (int k = 0; k < 2; ++k) acc[ai][bj][m][n] = __builtin_amdgcn_mfma_f32_16x16x32_bf16(Bt[n][k], At[m][k], acc[ai][bj][m][n], 0, 0, 0); } } \
        __builtin_amdgcn_s_setprio(0); } while (0)
#define PG8_WAIT_V(n) asm volatile("s_waitcnt vmcnt(" #n ")" ::: "memory")
#define PG8_WAIT_L(n) asm volatile("s_waitcnt lgkmcnt(" #n ")" ::: "memory")
#define PG8_BAR __builtin_amdgcn_s_barrier()
#define PG8_SCHED __builtin_amdgcn_sched_barrier(0)
    Unit cur, nxt; int ui = 0;
    if (!S.next(0, cur)) return;
    f32x4 acc[2][2][4][2];
#pragma unroll
    for (int a = 0; a < 2; ++a)
#pragma unroll
        for (int b = 0; b < 2; ++b)
#pragma unroll
            for (int m = 0; m < 4; ++m)
#pragma unroll
                for (int n = 0; n < 2; ++n) acc[a][b][m][n] = (f32x4){0.f, 0.f, 0.f, 0.f};
    typedef int i32x4_ __attribute__((ext_vector_type(4))); typedef int i32x8_ __attribute__((ext_vector_type(8)));
    bf16x8 At[4][2], B0[2][2], B1[2][2]; i32x8_ At8[4], B08[2], B18[2];
    unsigned cA, cB; S.ptrs(cur, cA, cB);
    int nslot = cur.slot;
    bool lite = false; if constexpr (Sched::LITE) lite = cur.lite != 0;
    PG8_STAGE(PG8_SB(0, 0), cB, voffB); PG8_STAGE(PG8_SB(0, 1), cB + hstepB, voffB); PG8_STAGE_A(PG8_SA(0, 0), cA, 0, false); PG8_STAGE_A(PG8_SA(0, 1), cA, 1, false);
    if (wr == 1) PG8_BAR;
    PG8_WAIT_V(2); PG8_BAR;
    PG8_STAGE(PG8_SB(1, 0), cB + kstep, voffB); PG8_STAGE_A(PG8_SA(1, 0), cA + kstep, 0, false); PG8_STAGE(PG8_SB(1, 1), cB + hstepB + kstep, voffB);
    PG8_WAIT_V(6); PG8_BAR;
    for (;;) {
        const bool has_next = S.next(ui + 1, nxt);
        unsigned nA = cA, nB = cB; if (has_next) S.ptrs(nxt, nA, nB);
        nslot = has_next ? nxt.slot : cur.slot;
#define PG8_ON(...) __VA_ARGS__
#define PG8_OFF(...)
#define PG8_KLOOP(H1) _Pragma("unroll 1") \
        for (int t = 0; t < nt; t += 2) { \
            asm volatile("" : "+s"(ldsw));                                     \
            const bool last = (t == nt - 2); \
            const unsigned a1 = cA + (unsigned)(t + 1) * kstep; \
            const unsigned a2 = last ? nA : cA + (unsigned)(t + 2) * kstep, b2 = last ? nB : cB + (unsigned)(t + 2) * kstep; \
            const unsigned a3 = a2 + kstep, b3 = b2 + kstep; \
            PG8_LDB(B0, 0, 0); PG8_LDB(B1, 0, 1); PG8_SCHED; PG8_LDA(At, 0, 0); PG8_STAGE_A(PG8_SA(1, 1), a1, 1, false); \
            PG8_WAIT_V(8); PG8_WAIT_L(0); PG8_BAR; PG8_MMA(0, 0, At, B0); PG8_MMA(0, 1, At, B1); PG8_BAR; PG8_SCHED; \
            H1(PG8_LDA(At, 0, 1);) PG8_STAGE(PG8_SB(0, 0), b2, voffB); PG8_STAGE(PG8_SB(0, 1), b2 + hstepB, voffB); PG8_STAGE_A(PG8_SA(0, 0), a2, 0, last); \
            PG8_WAIT_V(8); PG8_WAIT_L(0); PG8_BAR; H1(PG8_MMA(1, 0, At, B0); PG8_MMA(1, 1, At, B1);) PG8_BAR; PG8_SCHED; \
            PG8_LDB(B0, 1, 0); PG8_LDB(B1, 1, 1); PG8_SCHED; PG8_LDA(At, 1, 0); PG8_STAGE_A(PG8_SA(0, 1), a2, 1, last); \
            PG8_WAIT_V(8); PG8_WAIT_L(0); PG8_BAR; PG8_MMA(0, 0, At, B0); PG8_MMA(0, 1, At, B1); PG8_BAR; PG8_SCHED; \
            H1(PG8_LDA(At, 1, 1);) PG8_STAGE(PG8_SB(1, 0), b3, voffB); PG8_STAGE(PG8_SB(1, 1), b3 + hstepB, voffB); PG8_STAGE_A(PG8_SA(1, 0), a3, 0, last); \
            PG8_WAIT_V(8); PG8_WAIT_L(0); PG8_BAR; H1(PG8_MMA(1, 0, At, B0); PG8_MMA(1, 1, At, B1);) PG8_BAR; PG8_SCHED; \
        }
        if (Sched::LITE && lite) { PG8_KLOOP(PG8_OFF) } else { PG8_KLOOP(PG8_ON) }
#undef PG8_KLOOP
#undef PG8_ON
#undef PG8_OFF
        if (wr == 0) PG8_BAR;
        if constexpr (I8) {
#pragma unroll
            for (int a = 0; a < 2; ++a)
#pragma unroll
                for (int b = 0; b < 2; ++b)
#pragma unroll
                    for (int m = 0; m < 4; ++m)
#pragma unroll
                        for (int n = 0; n < 2; ++n) acc[a][b][m][n] = i2f4(acc[a][b][m][n]);
        }
        E(acc, cur, wr, wc, fr, fq);
        if (!has_next) break;
#pragma unroll
        for (int a = 0; a < 2; ++a)
#pragma unroll
            for (int b = 0; b < 2; ++b)
#pragma unroll
                for (int m = 0; m < 4; ++m)
#pragma unroll
                    for (int n = 0; n < 2; ++n) acc[a][b][m][n] = (f32x4){0.f, 0.f, 0.f, 0.f};
        cur = nxt; cA = nA; cB = nB; ++ui;
        if constexpr (Sched::LITE) lite = cur.lite != 0;
        if (wr == 1) PG8_BAR;
    }
    PG8_WAIT_V(0);
    PG8_BAR;
#undef PG8_SA
#undef PG8_SB
#undef PG8_STAGE
#undef PG8_STAGE_A
#undef PG8_LDA
#undef PG8_LDB
#undef PG8_MMA
#undef PG8_WAIT_V
#undef PG8_WAIT_L
#undef PG8_BAR
#undef PG8_SCHED
}
}
using pg8::Unit;
typedef const f32x4 (&AccRef)[2][2][4][2];

struct Args { const float* in[16]; float* out; unsigned char* ws; int ph_lo, ph_hi; };

struct Frame {
    LAS unsigned char* lds; unsigned char* ldsg;
    unsigned char* ws;
    int tid, lane, wave, G, bid;
};
template <class Tp> __device__ __forceinline__ Tp* wsp(const Frame& F, size_t off) { return (Tp*)(F.ws + off); }
enum { I_X = 0, I_NORM_MIX = 1, I_W_IN = 2, I_GN_W = 3, I_W_BM = 4, I_W_BR = 5, I_W_OUT = 6, I_NORM_FFN = 7, I_W_RG = 8, I_B_RG = 9, I_W_RE = 10, I_B_RE = 11, I_W_EG = 12, I_W_EU = 13, I_W_ED = 14, I_NORM_FINAL = 15 };


constexpr int CW_BAR = 4096;
#define XB_TMO      128
#define XB_XCNT(j)  (256  + 64 * (j))
#define XB_XSUB(j)  (1280 + 64 * (j))
#define XB_XGEN(j)  (2304 + 64 * (j))
#define XB_TOP      3328
#define XB_TOPGEN   3392
#define XCD_BAR_WORDS 3456
#define XB_SPIN_CAP (1u << 22)
__device__ __forceinline__ unsigned xb_ld(unsigned* p)              { return __hip_atomic_load(p, __ATOMIC_RELAXED, __HIP_MEMORY_SCOPE_AGENT); }
__device__ __forceinline__ unsigned xb_add(unsigned* p, unsigned v) { return __hip_atomic_fetch_add(p, v, __ATOMIC_RELAXED, __HIP_MEMORY_SCOPE_AGENT); }
__device__ __forceinline__ unsigned xb_xcc_id() { return (unsigned)__builtin_amdgcn_s_getreg((3 << 11) | 20) & 0xFu; }
#define XB_SPIN(cond, bar) do { unsigned _sp = 0; while (cond) { __builtin_amdgcn_s_sleep(1); \
    if ((++_sp & 255u) == 0u) { if (xb_ld(&(bar)[XB_TMO])) break; if (_sp > XB_SPIN_CAP) { atomicAdd(&(bar)[XB_TMO], 1u); break; } } } } while (0)
struct XcdBarrier { unsigned* bar; unsigned x; volatile LAS unsigned* st; };
__device__ __forceinline__ XcdBarrier xcd_barrier_post(unsigned* bar, volatile LAS unsigned* st) {
    XcdBarrier b; b.bar = bar; b.x = xb_xcc_id(); b.st = st;
    if (threadIdx.x == 0) (void)xb_add(&bar[XB_XCNT(b.x)], 1u);
    return b;
}
__device__ __forceinline__ void xcd_barrier_complete(unsigned* bar, unsigned x, unsigned& nloc, unsigned& nx) {
    const unsigned G = gridDim.x * gridDim.y * gridDim.z;
    unsigned sum, cnt, mine, sp = 0u;
    for (;;) {
        sum = 0u; cnt = 0u; mine = 0u;
#pragma unroll
        for (unsigned j = 0; j < 16; ++j) { const unsigned c = xb_ld(&bar[XB_XCNT(j)]); sum += c; cnt += (c > 0u) ? 1u : 0u; mine = (j == x) ? c : mine; }
        if (sum == G) break;
        __builtin_amdgcn_s_sleep(1);
        if ((++sp & 255u) == 0u) { if (xb_ld(&bar[XB_TMO])) break; if (sp > XB_SPIN_CAP) { atomicAdd(&bar[XB_TMO], 1u); break; } }
    }
    nloc = mine > 0u ? mine : 1u; nx = cnt > 0u ? cnt : 1u;
}
__device__ __forceinline__ void xcd_barrier(const XcdBarrier& b) {
    asm volatile("s_waitcnt vmcnt(0)" ::: "memory");
    __syncthreads();
    if (threadIdx.x == 0) {
        unsigned* bar = b.bar;
        __builtin_amdgcn_s_waitcnt(0);
        unsigned nloc = b.st[0], nx = b.st[1];
        if (nloc == 0u) { xcd_barrier_complete(bar, b.x, nloc, nx); b.st[0] = nloc; b.st[1] = nx; }
        const unsigned old = xb_add(&bar[XB_XSUB(b.x)], 1u);
        const unsigned gen = old / nloc;
        if (old + 1u == (gen + 1u) * nloc) {
            __builtin_amdgcn_fence(__ATOMIC_RELEASE, "agent");
            asm volatile("s_waitcnt vmcnt(0)" ::: "memory");
            const unsigned og = xb_add(&bar[XB_TOP], 1u);
            const unsigned tg = og / nx;
            if (og + 1u == (tg + 1u) * nx) xb_add(&bar[XB_TOPGEN], 1u);
            else XB_SPIN(xb_ld(&bar[XB_TOPGEN]) == tg, bar);
            __builtin_amdgcn_fence(__ATOMIC_ACQUIRE, "agent");
            xb_add(&bar[XB_XGEN(b.x)], 1u);
            asm volatile("s_waitcnt vmcnt(0)" ::: "memory");
        } else {
            XB_SPIN(xb_ld(&bar[XB_XGEN(b.x)]) == gen, bar);
            __builtin_amdgcn_fence(__ATOMIC_ACQUIRE, "agent");
            asm volatile("s_waitcnt vmcnt(0)" ::: "memory");
        }
    }
    __syncthreads();
}

constexpr float W_IN_SCALE = 1024.0f;
struct TItem { const float* src; const float* ksc; bf16* dst; int N, K; float fp8; };
__device__ __forceinline__ int win_drow(int n0, int& fp8) {
    fp8 = 1;
    if (n0 < 3072) return n0;
    if (n0 < 5120) { const int t0 = (n0 - 3072) & ~255, c = n0 & 255, hl = c >> 7, d = c & 127, half = d >> 6, i = d & 63; return 9216 + t0 + half * 128 + hl * 64 + i; }
    if (n0 < 7168) return n0 - 5120 + 11264;
    return n0 - 7168 + 3072;
}
constexpr int TI_IN8 = 16 * 416, TI_IN = TI_IN8, TI_WM = 8 * 64, TI_WR = 16 * 64, TI_WO = 16 * 64, TI_E = 32 * 256;
constexpr int TI_DENSE = TI_IN + TI_WM + TI_WR + TI_WO, TI_ALL = TI_DENSE + 3 * TI_E;
__device__ __forceinline__ TItem titem_decode(const Frame& F, const Args& A, int it, int lane) {
    const float* W; const float* ksc = nullptr; bf16* WT; int K, N, k0, n0, drow0, fp8 = 0; unsigned char* W8 = F.ws + WS_WIN8; float s8 = 64.f;
    int r = it;
    if (r < TI_IN) { const int kb = r / 416, nb = r % 416; W = A.in[I_W_IN]; K = 2048; N = NIN; WT = nullptr; n0 = nb * 32; drow0 = win_drow(n0, fp8); k0 = kb * 128; s8 = -W_IN_SCALE; }
    else if ((r -= TI_IN) < TI_WM) { const int kb = r / 64, nb = r % 64; W = A.in[I_W_BM]; K = 1024; N = 2048; WT = nullptr; fp8 = 1; W8 = F.ws + WS_WMT; s8 = 32.f; k0 = kb * 128; n0 = nb * 32; drow0 = n0; }
    else if ((r -= TI_WM) < TI_WR) { const int kb = r / 64, nb = r % 64; W = A.in[I_W_BR]; K = 2048; N = 2048; WT = nullptr; fp8 = 1; W8 = F.ws + WS_WRT2; s8 = 32.f; k0 = kb * 128; n0 = nb * 32; drow0 = n0; }
    else if ((r -= TI_WR) < TI_WO) { const int kb = r / 64, nb = r % 64; W = A.in[I_W_OUT]; K = 2048; N = 2048; WT = nullptr; fp8 = 1; W8 = F.ws + WS_WOT; s8 = -W_IN_SCALE; k0 = kb * 128; n0 = nb * 32; drow0 = n0; }
    else if ((r -= TI_WO) < 2 * TI_E) { const int up = r >= TI_E; if (up) r -= TI_E; const int e = r >> 8, q = r & 255, kb = q >> 4, nb = q & 15;
        W = (up ? A.in[I_W_EU] : A.in[I_W_EG]) + (size_t)e * 2048 * 512; ksc = A.in[I_NORM_FFN]; K = 2048; N = 512; WT = nullptr; fp8 = 1; W8 = F.ws + WS_W1T; s8 = 64.f; k0 = kb * 128; n0 = nb * 32; drow0 = e * 1024 + (n0 >> 7) * 256 + up * 128 + (n0 & 127); }
    else { r -= 2 * TI_E; const int e = r >> 8, q = r & 255, kb = q >> 6, nb = q & 63; W = A.in[I_W_ED] + (size_t)e * 512 * 2048; K = 512; N = 2048; WT = nullptr; fp8 = 1; W8 = F.ws + WS_W2T; s8 = 32.f; k0 = kb * 128; n0 = nb * 32; drow0 = e * 2048 + n0; }
    const int c = lane & 7, g = (lane >> 3) * (fp8 ? 16 : 8);
    TItem t; t.src = W + (size_t)(k0 + g) * N + n0 + 4 * c; t.ksc = ksc ? ksc + k0 + g : nullptr; t.N = N; t.K = K; t.fp8 = fp8 ? s8 : 0.f;
    if (fp8) t.dst = (bf16*)(W8 + (size_t)(drow0 + 4 * c) * K + k0 + g); else t.dst = WT + (size_t)(drow0 + 4 * c) * K + k0 + g;
    return t;
}
__device__ __forceinline__ void titem_load(const TItem& t, f32x4 (&v)[16]) {
#pragma unroll
    for (int i = 0; i < 8; ++i) v[i] = __builtin_nontemporal_load((const GAS f32x4*)(t.src + (size_t)i * t.N));
    if (t.fp8 != 0.f) {
#pragma unroll
        for (int i = 8; i < 16; ++i) v[i] = __builtin_nontemporal_load((const GAS f32x4*)(t.src + (size_t)i * t.N)); }
}
__device__ __forceinline__ void titem_store(const TItem& t, f32x4 (&v)[16], unsigned char* ws) {
    if (t.fp8 != 0.f) {
        if (t.ksc) {
#pragma unroll
            for (int q = 0; q < 4; ++q) { const f32x4 sq = *(const GAS f32x4*)(t.ksc + 4 * q); v[4 * q] *= sq.x; v[4 * q + 1] *= sq.y; v[4 * q + 2] *= sq.z; v[4 * q + 3] *= sq.w; } }
        if (t.fp8 < 0.f) { const float s = -t.fp8;
#define I8C(x_) __builtin_amdgcn_fmed3f((x_) * s, -127.0f, 127.0f)
#pragma unroll
            for (int j = 0; j < 4; ++j) { u32x4 o; o.x = pk4_i8(I8C(v[0][j]), I8C(v[1][j]), I8C(v[2][j]), I8C(v[3][j])); o.y = pk4_i8(I8C(v[4][j]), I8C(v[5][j]), I8C(v[6][j]), I8C(v[7][j]));
                o.z = pk4_i8(I8C(v[8][j]), I8C(v[9][j]), I8C(v[10][j]), I8C(v[11][j])); o.w = pk4_i8(I8C(v[12][j]), I8C(v[13][j]), I8C(v[14][j]), I8C(v[15][j]));
                st16_wt(ws, (unsigned char*)t.dst + (size_t)j * t.K, o); }
#undef I8C
            return; }
        const float s = t.fp8;
#pragma unroll
        for (int j = 0; j < 4; ++j) { u32x4 o; o.x = pk4_fp8(v[0][j] * s, v[1][j] * s, v[2][j] * s, v[3][j] * s); o.y = pk4_fp8(v[4][j] * s, v[5][j] * s, v[6][j] * s, v[7][j] * s);
            o.z = pk4_fp8(v[8][j] * s, v[9][j] * s, v[10][j] * s, v[11][j] * s); o.w = pk4_fp8(v[12][j] * s, v[13][j] * s, v[14][j] * s, v[15][j] * s);
            st16_wt(ws, (unsigned char*)t.dst + (size_t)j * t.K, o); }
        return; }
#pragma unroll
    for (int j = 0; j < 4; ++j) { u32x4 o; o.x = pk2(v[0][j], v[1][j]); o.y = pk2(v[2][j], v[3][j]); o.z = pk2(v[4][j], v[5][j]); o.w = pk2(v[6][j], v[7][j]);
        st16_wt(ws, t.dst + (size_t)j * t.K, o); }
}
__device__ __forceinline__ void transpose_items(Frame& F, const Args& A, int first, int last, int start, int NGW) {
    const int lane = F.lane;
    int it = first + start; if (it >= last) return;
    TItem cur = titem_decode(F, A, it, lane); f32x4 v[16]; titem_load(cur, v);
    for (;;) {
        const int nx = it + NGW; const bool more = nx < last;
        TItem nxt = cur; f32x4 w[16];
        if (more) { nxt = titem_decode(F, A, nx, lane); titem_load(nxt, w); }
        titem_store(cur, v, F.ws);
        if (!more) break;
        cur = nxt; it = nx;
#pragma unroll
        for (int i = 0; i < 16; ++i) v[i] = w[i];
    }
}
constexpr size_t OFF_FILL = 228 * 1024;
constexpr int FILL_A_FIRST = TI_IN, FILL_A_CHUNKS = (TI_ALL - TI_E - TI_IN) / 32, FILL_B_FIRST = TI_ALL - TI_E, FILL_B_CHUNKS = TI_E / 32;
static_assert((TI_ALL - TI_E - TI_IN) % 32 == 0 && TI_E % 32 == 0, "filler chunks");
__device__ __forceinline__ void filler_convert(Frame& F, const Args& A, int which, int max_chunks) {
    volatile LAS int* slot = (volatile LAS int*)(F.lds + MISC_OFF + 2048);
    unsigned* ctr = (unsigned*)(F.ws + OFF_FILL) + 64 * which;
    const int first = which ? FILL_B_FIRST : FILL_A_FIRST, nch = which ? FILL_B_CHUNKS : FILL_A_CHUNKS;
    if (max_chunks <= 0) return;
    int nxt = 0; if (F.tid == 0) nxt = (int)atomicAdd(ctr, 1u);
    for (int n_ = 0; n_ < max_chunks; ++n_) {
        __syncthreads();
        if (F.tid == 0) *slot = nxt;
        __syncthreads();
        const int ch = *slot;
        if (ch >= nch) break;
        if (F.tid == 0) nxt = (int)atomicAdd(ctr, 1u);
        transpose_items(F, A, first + ch * 32, first + ch * 32 + 32, F.wave, 8);
    }
}
__device__ __forceinline__ void p0_prologue(Frame& F, const Args& A) {
    const int gw = F.bid * 8 + F.wave, NGW = F.G * 8, lane = F.lane;
    transpose_items(F, A, 0, TI_IN, gw, NGW);
    f32x4 w[8];
    { const GAS f32x4* wr = (const GAS f32x4*)A.in[I_NORM_MIX] + lane;
#pragma unroll
      for (int j = 0; j < 8; ++j) w[j] = wr[64 * j]; }
    int m = gw; if (m >= T) return;
    f32x4 v[8], nx[8];
    { const GAS f32x4* xr = (const GAS f32x4*)(A.in[I_X] + (size_t)m * DM) + lane;
#pragma unroll
      for (int j = 0; j < 8; ++j) v[j] = xr[64 * j]; }
    for (;;) {
        const int mn = m + NGW; const bool more = mn < T;
        if (more) { const GAS f32x4* xr = (const GAS f32x4*)(A.in[I_X] + (size_t)mn * DM) + lane;
#pragma unroll
            for (int j = 0; j < 8; ++j) nx[j] = xr[64 * j]; }
        float s = 0.f;
#pragma unroll
        for (int j = 0; j < 8; ++j) s += (v[j].x * v[j].x + v[j].y * v[j].y) + (v[j].z * v[j].z + v[j].w * v[j].w);
        const float rstd = 1.0f / sqrtf(wave_sum(s) * (1.0f / DM) + RMS_EPS);
        float am = 0.f;
#pragma unroll
        for (int j = 0; j < 8; ++j) { v[j] = v[j] * rstd * w[j]; am = fmaxf(fmaxf(am, fmaxf(fabsf(v[j].x), fabsf(v[j].y))), fmaxf(fabsf(v[j].z), fabsf(v[j].w))); }
        am = fmaxf(wave_max(am), 1e-20f);
        const float qs = 127.0f / am;
        GAS unsigned* o4 = (GAS unsigned*)(F.ws + WS_HB8 + (size_t)m * DM) + lane;
#pragma unroll
        for (int j = 0; j < 8; ++j) o4[64 * j] = pk4_i8(v[j].x * qs, v[j].y * qs, v[j].z * qs, v[j].w * qs);
        if (lane == 0) wsp<float>(F, WS_HS)[m] = am * (1.0f / 127.0f);
        if (!more) break;
        m = mn;
#pragma unroll
        for (int j = 0; j < 8; ++j) v[j] = nx[j];
    }
}
__device__ __forceinline__ void p1_tables(Frame& F, const Args& A, int first) {
    const int t0 = (F.bid - first) * 512 + F.tid, tstride = (F.G - first) * 512;
    { float* COS = wsp<float>(F, WS_COS); float* SIN = wsp<float>(F, WS_SIN);
      for (int idx = t0; idx < SEQ * 64; idx += tstride) { const int s = idx >> 6, i = idx & 63;
          const float inv = (float)pow(10000.0, -(double)i / 64.0); const float ang = (float)s * inv;
          COS[idx] = (float)cos((double)ang); SIN[idx] = (float)sin((double)ang); } }
    { bf16* WRT = wsp<bf16>(F, WS_WRT);
      for (int idx = t0; idx < 64 * 2048; idx += tstride) { const int j = idx >> 11, k = idx & 2047; float v = 0.f;
          if (j < 4) v = A.in[I_W_RG][k * 4 + j]; else if (j < 36) { const int g = (j - 4) >> 3, e = (j - 4) & 7; v = A.in[I_W_RE][((size_t)g * 2048 + k) * 8 + e]; }
          WRT[idx] = (bf16)f2bf(v * A.in[I_NORM_FFN][k]); } }
}

__device__ __forceinline__ void win_bf16_handoff(Frame& F, const Args& A, unsigned* bar) {
    unsigned* cw = (unsigned*)(F.ws + OFF_FILL) + 128;
    const int first = F.G / 2, nconv = F.G - first;
    if (F.bid >= first) {
        transpose_items(F, A, TI_IN8, TI_IN, (F.bid - first) * 8 + F.wave, nconv * 8);
        p1_tables(F, A, first);
        asm volatile("s_waitcnt vmcnt(0)" ::: "memory");
        __syncthreads();
        if (F.tid == 0) { __builtin_amdgcn_fence(__ATOMIC_RELEASE, "agent"); asm volatile("s_waitcnt vmcnt(0)" ::: "memory"); (void)xb_add(cw, 1u); }
    }
    if (F.tid == 0) { XB_SPIN(xb_ld(cw) < (unsigned)nconv, bar); __builtin_amdgcn_fence(__ATOMIC_ACQUIRE, "agent"); asm volatile("s_waitcnt vmcnt(0)" ::: "memory"); }
    __syncthreads();
}

struct SchedIn8 {
    static constexpr bool GATHER = false, LITE = true;
    int G, c; const char* ws;
    __device__ __forceinline__ bool next(int i, Unit& u) const {
        int L = i * G + c; if (L >= 1536 + 256) return false;
        u.lite = 0; u.half = 0;
        if (L >= 1536) { const int hu = L - 1536; u.lite = 1; u.half = hu & 1; L = 1536 + (hu >> 1); }
        if (L < 1408) { int pm, j; pg8::tile_of(L, 32, 44, pm, j); u.pm = pm; u.pn = j < 12 ? j : (j < 36 ? 16 + j : j - 24); u.kind = 0; u.aux = j; }
        else { const int q = L - 1408; u.pm = q >> 5; u.pn = q & 31; u.kind = 1; u.aux = 44 + u.pm; }
        u.slot = i; return true;
    }
    __device__ __forceinline__ void ptrs(const Unit& u, unsigned& a, unsigned& b) const {
        constexpr unsigned ts = 256u * 2048u, H = (unsigned)WS_HB8, W = (unsigned)WS_WIN8;
        if (u.kind == 0) { a = H + (unsigned)u.pm * ts; b = W + (unsigned)u.aux * ts; } else { a = W + (unsigned)u.aux * ts + (unsigned)u.half * (128u * 2048u); b = H + (unsigned)u.pn * ts; }
    }
    __device__ __forceinline__ int arow(int, int) const { return 0; }
};
struct EpiInProj {
    unsigned char* ws;
    __device__ __forceinline__ void operator()(AccRef acc, const Unit& u, int wr, int wc, int fr, int fq) const {
        asm volatile("" : "+v"(fr), "+v"(fq));
        bf16* MQ = (bf16*)(ws + WS_MQ); bf16* RQ = (bf16*)(ws + WS_RQ); bf16* RVT = (bf16*)(ws + WS_RVT); bf16* RG = (bf16*)(ws + WS_RG); float* KMEAN = (float*)(ws + (wr ? WS_KMEAN1 : OFF_KMEAN)); const float* COS = (const float*)(ws + WS_COS); const float* SIN = (const float*)(ws + WS_SIN);
        const float* HS = (const float*)(ws + WS_HS);
        if (u.kind == 1) {
            const int b = u.pn >> 4, s0 = (u.pn & 15) * 256 + wc * 32 + 8 * fq;
            bf16* base = RVT + ((size_t)(b * 8 + u.pm) * 256) * 4096 + s0;
            const float* hs = HS + (size_t)u.pn * 256 + wc * 32 + 8 * fq;
            f32x4 cs[2][2];
#pragma unroll
            for (int bj = 0; bj < 2; ++bj)
#pragma unroll
                for (int n = 0; n < 2; ++n) cs[bj][n] = *(const GAS f32x4*)(hs + bj * 128 + 4 * n) * (1.0f / W_IN_SCALE);
#pragma unroll
            for (int ai = 0; ai < 2; ++ai)
#pragma unroll
                for (int m = 0; m < 4; ++m) { if (ai == 1 && u.lite) continue;
                    const int dv = (u.lite ? u.half : ai) * 128 + wr * 64 + m * 16 + fr;
#pragma unroll
                    for (int bj = 0; bj < 2; ++bj) *(GAS u32x4*)(base + (size_t)dv * 4096 + bj * 128) = pack8(acc[ai][bj][m][0] * cs[bj][0], acc[ai][bj][m][1] * cs[bj][1]); }
            return;
        }
        const int pn = u.pn, b = u.pm >> 4;
#define sb ((u.pm & 15) * 256 + wr * 64 + fr)
#define c8 (wc * 32 + 8 * fq)
#define RS(ai_, m_) (HS[(size_t)u.pm * 256 + wr * 64 + fr + (ai_) * 128 + (m_) * 16] * (1.0f / W_IN_SCALE))
        if (pn < 12) {
            asm volatile("" : "+v"(fr), "+v"(fq));
            const int which = pn >> 2; bf16* dst = MQ + (size_t)which * (8u << 20);
#pragma unroll
            for (int bj = 0; bj < 2; ++bj) { const int head = (pn & 3) * 2 + bj; bf16* hb = dst + ((size_t)(b * 8 + head) * 4096) * 128 + c8;
#pragma unroll
                for (int ai = 0; ai < 2; ++ai)
#pragma unroll
                    for (int m = 0; m < 4; ++m) *(GAS u32x4*)(hb + (size_t)(sb + ai * 128 + m * 16) * 128) = pack8(acc[ai][bj][m][0] * RS(ai, m), acc[ai][bj][m][1] * RS(ai, m)); }
            if (which == 1) {
#pragma unroll
                for (int bj = 0; bj < 2; ++bj) { const int head = (pn & 3) * 2 + bj;
#pragma unroll
                    for (int n = 0; n < 2; ++n) { f32x4 s = (f32x4){0.f, 0.f, 0.f, 0.f};
#pragma unroll
                        for (int ai = 0; ai < 2; ++ai)
#pragma unroll
                            for (int m = 0; m < 4; ++m) s += acc[ai][bj][m][n] * RS(ai, m);
#pragma unroll
                        for (int j = 0; j < 4; ++j) { float v = s[j]; v += __shfl_xor(v, 1); v += __shfl_xor(v, 2); v += __shfl_xor(v, 4); v += __shfl_xor(v, 8);
                            if (fr == 0) KMEAN[((size_t)((b * 8 + head) * 16 + (u.pm & 15))) * 128 + c8 + 4 * n + j] = v * (1.0f / 256.0f); } } }
            }
        } else if (pn < 20) {
            asm volatile("" : "+v"(fr), "+v"(fq));
            const bool isk = pn >= 16; const int head = ((pn - 12) & 3) * 2 + (wc >> 1), i0 = (wc & 1) * 32 + 8 * fq;
            bf16* hb = RQ + (isk ? (size_t)(8u << 20) : (size_t)0) + ((size_t)(b * 8 + head) * 4096) * 128 + i0;
            const float nlg = -log2f(1.0f - exp2f(-(5.0f + (float)head)));
#pragma unroll
            for (int ai = 0; ai < 2; ++ai)
#pragma unroll
                for (int m = 0; m < 4; ++m) { const int s = sb + ai * 128 + m * 16;
                    const float sc = (isk ? 0.08838834764831845f * exp2f((float)((s & 127) + 1) * nlg) : 1.0f) * RS(ai, m);
                    const GAS f32x4* cp = (const GAS f32x4*)(COS + (size_t)s * 64 + i0); const GAS f32x4* sp = (const GAS f32x4*)(SIN + (size_t)s * 64 + i0);
                    f32x4 o1[2], o2[2];
#pragma unroll
                    for (int n = 0; n < 2; ++n) { const f32x4 c = cp[n], sn = sp[n], x1 = acc[ai][0][m][n], x2 = acc[ai][1][m][n];
                        o1[n] = (x1 * c - x2 * sn) * sc; o2[n] = (x1 * sn + x2 * c) * sc; }
                    *(GAS u32x4*)(hb + (size_t)s * 128) = pack8(o1[0], o1[1]); *(GAS u32x4*)(hb + (size_t)s * 128 + 64) = pack8(o2[0], o2[1]); }
        } else {
            asm volatile("" : "+v"(fr), "+v"(fq));
            const int which = pn < 36 ? 0 : (pn < 44 ? 1 : 2); bf16* dst = RG + (size_t)which * (16u << 20);
            const int col0 = (pn - 28 - 8 * which) * 256 + c8;
#pragma unroll
            for (int ai = 0; ai < 2; ++ai)
#pragma unroll
                for (int m = 0; m < 4; ++m) { bf16* rp = dst + (size_t)(u.pm * 256 + wr * 64 + fr + ai * 128 + m * 16) * 2048 + col0;
#pragma unroll
                    for (int bj = 0; bj < 2; ++bj) { f32x4 v0 = acc[ai][bj][m][0] * RS(ai, m), v1 = acc[ai][bj][m][1] * RS(ai, m);
#pragma unroll
                        for (int j = 0; j < 4; ++j) { const float s0 = sigmoidf_(v0[j]), s1 = sigmoidf_(v1[j]); v0[j] = which == 0 ? v0[j] * s0 : s0; v1[j] = which == 0 ? v1[j] * s1 : s1; }
                        if (which == 1) { u32x2 o8; o8.x = pk4_fp8(v0.x, v0.y, v0.z, v0.w); o8.y = pk4_fp8(v1.x, v1.y, v1.z, v1.w);
                            *(GAS u32x2*)((unsigned char*)(ws + WS_GA) + (size_t)(u.pm * 256 + wr * 64 + fr + ai * 128 + m * 16) * 2048 + col0 + bj * 128) = o8; }
                        else *(GAS u32x4*)(rp + bj * 128) = pack8(v0, v1); } }
        }
#undef RS
#undef sb
#undef c8
    }
};
namespace att {
constexpr int D = 128, OSTR = 1024;
constexpr float THR = 8.f;
constexpr bool WSKIP = false;
constexpr float SCALE = 0.08838834764831845f;
constexpr int NW = 8, QBLK = 32, KVBLK = 64, QB = NW * QBLK;
constexpr int SHM_V = KVBLK * D * 2, SHM_K = KVBLK * D * 2;
constexpr int LDS_BYTES = 2 * SHM_V + 2 * SHM_K + NW * 64 * 4;
typedef short bf16x8 __attribute__((ext_vector_type(8)));
typedef short s16x4 __attribute__((ext_vector_type(4)));
typedef float f32x16 __attribute__((ext_vector_type(16)));
typedef float f32x4 __attribute__((ext_vector_type(4)));
__device__ __forceinline__ unsigned moba_select(const bf16x8* qr, const __attribute__((address_space(3))) float* KM, int qb, int hi) {
    if (qb == 0) return 0u;
    const float NEG = -__builtin_inff();
    float v1 = NEG, v2 = NEG, v3 = NEG; int i1 = 0, i2 = 0, i3 = 0;
    __builtin_amdgcn_sched_barrier(0);
#pragma unroll 1
    for (int j = 0; j < qb; ++j) {
        const __attribute__((address_space(3))) f32x4* km = (const __attribute__((address_space(3))) f32x4*)(KM + j * 128 + hi * 8); float a = 0.f;
#pragma unroll
        for (int d0 = 0; d0 < 8; ++d0) { const f32x4 k0 = km[d0 * 4], k1 = km[d0 * 4 + 1]; const bf16x8 q = qr[d0];
#define QF(e) __uint_as_float(((unsigned)(unsigned short)q[e]) << 16)
            a = fmaf(QF(0), k0.x, a); a = fmaf(QF(1), k0.y, a); a = fmaf(QF(2), k0.z, a); a = fmaf(QF(3), k0.w, a);
            a = fmaf(QF(4), k1.x, a); a = fmaf(QF(5), k1.y, a); a = fmaf(QF(6), k1.z, a); a = fmaf(QF(7), k1.w, a);
#undef QF
        }
        a += __shfl_xor(a, 32);
        const bool g1 = a > v1, g2 = a > v2, g3 = a > v3;
        v3 = g2 ? v2 : (g3 ? a : v3); i3 = g2 ? i2 : (g3 ? j : i3);
        v2 = g1 ? v1 : (g2 ? a : v2); i2 = g1 ? i1 : (g2 ? j : i2);
        v1 = g1 ? a : v1; i1 = g1 ? j : i1;
        asm volatile("" : "+v"(v1), "+v"(v2), "+v"(v3));
    }
    unsigned sel = 0u;
    if (v1 > NEG) sel |= 1u << i1;
    if (v2 > NEG) sel |= 1u << i2;
    if (v3 > NEG) sel |= 1u << i3;
    asm volatile("" : "+v"(sel));
    __builtin_amdgcn_sched_barrier(0);
    return sel;
}
typedef unsigned u32x4 __attribute__((ext_vector_type(4)));
template <class A, class Bt> struct same_t { static constexpr bool v = false; };
template <class A> struct same_t<A, A> { static constexpr bool v = true; };

#define KSWZ(row, colB) ((row) * 256 + ((colB) ^ (((row) & 7) << 4)))
#define SBAR() __builtin_amdgcn_sched_barrier(0)
__device__ __forceinline__ int v_st(int k, int c) { const int kk = (k & ~0xC) | ((k & 4) << 1) | ((k & 8) >> 1); return ((kk >> 3) * 4 + (c >> 5)) * 512 + ((kk & 7) * 32 + (c & 31)) * 2; }
__device__ __forceinline__ int v_rd_base(int lane) { return ((lane & 3) << 3) | (((lane >> 2) & 3) << 6) | (((lane >> 4) & 1) << 5) | (((lane >> 5) & 1) << 8); }
constexpr int v_rd_off(int d0, int ks, int half) { return d0 * 512 + ks * 4096 + half * 2048; }
__device__ __forceinline__ int crow(int r, int hi) { return (r & 3) + 8 * (r >> 2) + 4 * hi; }
__device__ __forceinline__ unsigned cvtpk(float lo, float hi) {
    unsigned r; asm volatile("v_cvt_pk_bf16_f32 %0, %1, %2" : "=v"(r) : "v"(lo), "v"(hi)); return r;
}
__device__ __forceinline__ bf16x8 pack8(f32x4 a, f32x4 b) {
    u32x4 w = {cvtpk(a[0], a[1]), cvtpk(a[2], a[3]), cvtpk(b[0], b[1]), cvtpk(b[2], b[3])};
    return *reinterpret_cast<bf16x8*>(&w);
}
template <class T> __device__ __forceinline__ bf16x8 load8(const T* p) {
    if constexpr (same_t<T, float>::v) { return pack8(*(const f32x4*)p, *(const f32x4*)(p + 4)); }
    else { return *reinterpret_cast<const bf16x8*>(p); }
}
__device__ __forceinline__ void mask_tile(f32x16& p0, f32x16& p1, int dq, unsigned W) {
    const float NEG = -__builtin_inff();
#pragma unroll
    for (int r = 0; r < 16; ++r) {
        const int c = (r & 3) + 8 * (r >> 2);
        if ((unsigned)(dq - c) >= W) p0[r] = NEG;
        if ((unsigned)(dq - c - 32) >= W) p1[r] = NEG;
    }
}
__device__ __forceinline__ void partialSM(f32x16& p0, f32x16& p1, float& m_reg, float& mn, float& alpha, bool keep = true) {
    float pmax = p0[0]; for (int r = 1; r < 16; ++r) pmax = fmaxf(pmax, p0[r]); for (int r = 0; r < 16; ++r) pmax = fmaxf(pmax, p1[r]);
    { auto rr = __builtin_amdgcn_permlane32_swap(__float_as_uint(pmax), __float_as_uint(pmax), false, false);
      pmax = fmaxf(__uint_as_float(rr[0]), __uint_as_float(rr[1])); }
    pmax = keep ? pmax : -__builtin_inff();
    constexpr float C2 = 1.4426950408889634f * SCALE;
    if (__builtin_expect(__all((pmax - m_reg) * SCALE <= THR), 1)) { mn = m_reg; alpha = 1.f; }
    else { mn = fmaxf(m_reg, pmax); alpha = __builtin_amdgcn_exp2f((m_reg - mn) * C2); m_reg = mn; }
    const float mnL = keep ? -mn * C2 : -__builtin_inff(), c2 = keep ? C2 : 0.f;
    for (int r = 0; r < 16; ++r) p0[r] = fmaf(p0[r], c2, mnL); for (int r = 0; r < 16; ++r) p1[r] = fmaf(p1[r], c2, mnL);
    for (int r = 0; r < 16; ++r) p0[r] = __builtin_amdgcn_exp2f(p0[r]);
}
__device__ __forceinline__ void finishSM(f32x16& p0, f32x16& p1, float alpha, float& l_reg, bf16x8& pa0, bf16x8& pa1, bf16x8& pa2, bf16x8& pa3) {
    for (int r = 0; r < 16; ++r) p1[r] = __builtin_amdgcn_exp2f(p1[r]);
    float ps = 0; for (int r = 0; r < 16; ++r) ps += p0[r]; for (int r = 0; r < 16; ++r) ps += p1[r];
    { auto rr = __builtin_amdgcn_permlane32_swap(__float_as_uint(ps), __float_as_uint(ps), false, false);
      ps = __uint_as_float(rr[0]) + __uint_as_float(rr[1]); }
    l_reg = l_reg * alpha + ps;
#define PK4(P, B_, OUT) do { unsigned a0 = cvtpk(P[B_+0], P[B_+1]), a1 = cvtpk(P[B_+2], P[B_+3]);                          \
        unsigned b0 = cvtpk(P[B_+4], P[B_+5]), b1 = cvtpk(P[B_+6], P[B_+7]);                                             \
        auto r0 = __builtin_amdgcn_permlane32_swap(a0, b0, false, false); auto r1 = __builtin_amdgcn_permlane32_swap(a1, b1, false, false); \
        u32x4 w = {r0[0], r1[0], r0[1], r1[1]}; OUT = *reinterpret_cast<bf16x8*>(&w); } while (0)
    PK4(p0, 0, pa0); PK4(p0, 8, pa1); PK4(p1, 0, pa2); PK4(p1, 8, pa3);
#undef PK4
}
template <int KB, bool SK>
__device__ __forceinline__ void qkt(f32x16& p0, f32x16& p1, const char* K_lds, int r32, int hi, const bf16x8* qr, bool act) {
    if (SK && !act) { const float NEG = -__builtin_inff();
#pragma unroll
        for (int r = 0; r < 16; ++r) { p0[r] = NEG; p1[r] = NEG; } return; }
    p0 = f32x16{}; p1 = f32x16{};
    const char* kb[4];
#pragma unroll
    for (int dd = 0; dd < 4; ++dd) kb[dd] = K_lds + KB * SHM_K + KSWZ(r32, (dd * 16 + hi * 8) * 2);
#pragma unroll
    for (int d0 = 0; d0 < 8; ++d0) { const char* a = kb[d0 & 3] + (d0 >> 2) * 128;
        bf16x8 b0 = *reinterpret_cast<const bf16x8*>(a);
        bf16x8 b1 = *reinterpret_cast<const bf16x8*>(a + 32 * 256);
        p0 = __builtin_amdgcn_mfma_f32_32x32x16_bf16(b0, qr[d0], p0, 0, 0, 0);
        p1 = __builtin_amdgcn_mfma_f32_32x32x16_bf16(b1, qr[d0], p1, 0, 0, 0); }
}
template <int VB, bool SK>
__device__ __forceinline__ void pv_tile(f32x16* o, int vb0, bf16x8 pa0, bf16x8 pa1, bf16x8 pa2, bf16x8 pa3, bool act) {
    if (SK && !act) return;
#define TRRD(dst, off) asm volatile("ds_read_b64_tr_b16 %0, %1 offset:%2" : "=&v"(dst) : "v"(vb0), "i"(off) : "memory")
#define PV_D0(d0) do { s16x4 l0, l1, l2, l3, h0, h1, h2, h3; constexpr int b_ = VB * SHM_V + v_rd_off(d0, 0, 0);     \
        TRRD(l0, b_); TRRD(h0, b_ + 2048); TRRD(l1, b_ + 4096); TRRD(h1, b_ + 6144); TRRD(l2, b_ + 8192); TRRD(h2, b_ + 10240); TRRD(l3, b_ + 12288); TRRD(h3, b_ + 14336); \
        asm volatile("s_waitcnt lgkmcnt(0)" ::: "memory"); SBAR();                 \
        o[d0] = __builtin_amdgcn_mfma_f32_32x32x16_bf16(pa0, (bf16x8){l0[0], l0[1], l0[2], l0[3], h0[0], h0[1], h0[2], h0[3]}, o[d0], 0, 0, 0);   \
        o[d0] = __builtin_amdgcn_mfma_f32_32x32x16_bf16(pa1, (bf16x8){l1[0], l1[1], l1[2], l1[3], h1[0], h1[1], h1[2], h1[3]}, o[d0], 0, 0, 0);   \
        o[d0] = __builtin_amdgcn_mfma_f32_32x32x16_bf16(pa2, (bf16x8){l2[0], l2[1], l2[2], l2[3], h2[0], h2[1], h2[2], h2[3]}, o[d0], 0, 0, 0);   \
        o[d0] = __builtin_amdgcn_mfma_f32_32x32x16_bf16(pa3, (bf16x8){l3[0], l3[1], l3[2], l3[3], h3[0], h3[1], h3[2], h3[3]}, o[d0], 0, 0, 0); } while (0)
    PV_D0(0); PV_D0(1); PV_D0(2); PV_D0(3);
#undef PV_D0
#undef TRRD
}

template <class TIn, class TOut> struct BlockRef { const TIn* Q; const TIn* K; const TIn* V; TOut* O; int P0; const float* KM; };
template <class TIn> struct Seam {
    bf16x8 qr[8];
    bf16x8 st_v0, st_v1, st_k0, st_k1; f32x4 sf0, sf1, sf2, sf3;
    f32x4 tq[16];
};
__device__ __forceinline__ int swa_jlo(int P0, int W) { const int lowk = P0 - W + 1; return lowk > 0 ? lowk / KVBLK : 0; }
#define ROW(p, k0, rr) ((p) + (size_t)((k0) + (rr)) * D + sc)
#define VMW() asm volatile("s_waitcnt vmcnt(0)" ::: "memory")
#define VMWN(n) asm volatile("s_waitcnt vmcnt(%0)" :: "i"(n) : "memory")
#define SLOAD_H(Kp, Vp, k0) do { S.st_v0 = load8<TIn>(ROW(Vp, k0, sr)); S.st_v1 = load8<TIn>(ROW(Vp, k0, 32 + sr));              \
                         S.st_k0 = load8<TIn>(ROW(Kp, k0, sr)); S.st_k1 = load8<TIn>(ROW(Kp, k0, 32 + sr)); } while (0)
#define SWRITE_HK(bf) do { *(bf16x8*)(K_lds + (bf) * SHM_K + kws) = S.st_k0; *(bf16x8*)(K_lds + (bf) * SHM_K + kws + 32 * 256) = S.st_k1; } while (0)
#define SWRITE_HV(bf) do { *(bf16x8*)(V_lds + (bf) * SHM_V + vst0) = S.st_v0; *(bf16x8*)(V_lds + (bf) * SHM_V + vst1) = S.st_v1; } while (0)
#define SWRITE_H(bf) do { SWRITE_HV(bf); SWRITE_HK(bf); } while (0)
#define SLOAD_F(p, k0) do { S.sf0 = *(const f32x4*)ROW(p, k0, sr); S.sf1 = *(const f32x4*)(ROW(p, k0, sr) + 4);                \
                            S.sf2 = *(const f32x4*)ROW(p, k0, 32 + sr); S.sf3 = *(const f32x4*)(ROW(p, k0, 32 + sr) + 4); } while (0)
#define SWRITE_KF(bf) do { *(bf16x8*)(K_lds + (bf) * SHM_K + kws) = pack8(S.sf0, S.sf1); *(bf16x8*)(K_lds + (bf) * SHM_K + kws + 32 * 256) = pack8(S.sf2, S.sf3); } while (0)
#define SWRITE_VF(bf) do { *(bf16x8*)(V_lds + (bf) * SHM_V + vst0) = pack8(S.sf0, S.sf1); *(bf16x8*)(V_lds + (bf) * SHM_V + vst1) = pack8(S.sf2, S.sf3); } while (0)
template <class TIn, class TOut>
__device__ __forceinline__ void causal_swa_prime(const BlockRef<TIn, TOut>& cur, int W, char* lds, Seam<TIn>& S) {
    constexpr bool F32 = same_t<TIn, float>::v;
    const int tid = fresh_tid(), wid = __builtin_amdgcn_readfirstlane(tid >> 6), lane = tid & 63, r32 = lane & 31, hi = lane >> 5;
    const int sr = tid >> 4, sc = (tid & 15) * 8, kws = KSWZ(sr, sc * 2); char* K_lds = lds + 2 * SHM_V;
    const int kb0 = swa_jlo(cur.P0, W) * KVBLK;
    for (int d0 = 0; d0 < 8; ++d0) S.qr[d0] = load8<TIn>(cur.Q + (size_t)(wid * QBLK + r32) * D + d0 * 16 + hi * 8);
    if constexpr (F32) { SLOAD_F((const float*)cur.K, kb0); VMW(); SWRITE_KF(0); SBAR(); SLOAD_F((const float*)cur.V, kb0); }
    else { SLOAD_H(cur.K, cur.V, kb0); VMW(); SWRITE_HK(0); }
    __syncthreads();
}
template <class TIn, class TOut>
__device__ __forceinline__ void causal_swa_block(const BlockRef<TIn, TOut>& cur, const BlockRef<TIn, TOut>& nxt, int skv, int W, char* lds, Seam<TIn>& S) {
    constexpr bool F32 = same_t<TIn, float>::v;
    const int tid = fresh_tid(), wid = __builtin_amdgcn_readfirstlane(tid >> 6), lane = tid & 63, r32 = lane & 31, hi = lane >> 5;
    const int j_lo = swa_jlo(cur.P0, W);
    int j_hi = (cur.P0 + QB - 1) / KVBLK + 1; if (j_hi > skv / KVBLK) j_hi = skv / KVBLK;
    const int NT = j_hi - j_lo;
    const int kbn = swa_jlo(nxt.P0, W) * KVBLK;
    const int qlo = cur.P0 + wid * QBLK, qm = qlo + r32 - 4 * hi;
    char* V_lds = lds; char* K_lds = lds + 2 * SHM_V;
    float* ws = (float*)(lds + 2 * SHM_V + 2 * SHM_K) + wid * 64; float* li_l = ws, * al_l = ws + 32;
    { const unsigned sb_ = moba_select(S.qr, (const __attribute__((address_space(3))) float*)(lds + LDS_BYTES + 4096), cur.P0 >> 8, hi); ((unsigned*)(lds + LDS_BYTES))[tid] = sb_; }
    float m_reg = -1e30f, l_reg = 0; f32x16 o[4] = {};
    const int sr = tid >> 4, sc = (tid & 15) * 8, vst0 = v_st(sr, sc), vst1 = v_st(32 + sr, sc), kws = KSWZ(sr, sc * 2);
    const int vb0 = (int)(uintptr_t)V_lds + v_rd_base(lane);
    const TIn* Kh = cur.K; const TIn* Vh = cur.V;
#define RESC(a) do { if (__any((a) < 1.f)) { if (hi == 0) al_l[r32] = (a); asm volatile("s_waitcnt lgkmcnt(0)" ::: "memory");              \
                     for (int d_ = 0; d_ < 4; ++d_) for (int r = 0; r < 16; ++r) o[d_][r] *= al_l[crow(r, hi)]; } } while (0)
#define KBASE(t) ((j_lo + (t)) * KVBLK)
#define ACT(t) (KBASE(t) <= qlo + QBLK - 1 && KBASE(t) + KVBLK - 1 >= qlo - W + 1)
#define MASKT(P0_, P1_, t) do { const int kb_ = KBASE(t); keepT = true; \
        if (kb_ < cur.P0) { const unsigned selbits = ((const unsigned*)(lds + LDS_BYTES))[tid]; keepT = (selbits >> (kb_ >> 8)) & 1u; }     \
        else if (kb_ + KVBLK - 1 > qlo) mask_tile(P0_, P1_, qm - kb_, (unsigned)W); } while (0)
    constexpr int NQL = F32 ? 16 : 8;
    constexpr bool SK = WSKIP && !F32;
#define SEAM_K0() do { VMWN(NQL); if constexpr (F32) { SWRITE_KF(0); SBAR(); SLOAD_F((const float*)nxt.V, kbn); } else { SWRITE_HK(0); } SBAR(); } while (0)
    f32x16 pA0, pA1, pB0, pB1; float mnA, mnB, alA, alB; bf16x8 pa0, pa1, pa2, pa3;
    if constexpr (F32) { VMW(); SWRITE_VF(0); SBAR(); } else { SWRITE_HV(0); SBAR(); }
    if (NT > 1) { if constexpr (F32) SLOAD_F((const float*)Kh, KBASE(1)); else SLOAD_H(Kh, Vh, KBASE(1)); }
    SBAR(); qkt<0, SK>(pA0, pA1, K_lds, r32, hi, S.qr, ACT(0));
    if constexpr (F32) { if (NT > 1) { VMW(); SWRITE_KF(1); SBAR(); SLOAD_F((const float*)Vh, KBASE(1)); } }
    bool keepT = true;
    MASKT(pA0, pA1, 0); partialSM(pA0, pA1, m_reg, mnA, alA, keepT);
    if (NT > 1) { VMW(); if constexpr (F32) { SWRITE_VF(1); SBAR(); if (NT > 2) SLOAD_F((const float*)Kh, KBASE(2)); } else SWRITE_H(1); }
    __syncthreads();
#define HALF_STEP(PX0, PX1, mnX, alX, PY0, PY1, alY, t, KB, VB, SB) do {                                                      \
        SBAR(); qkt<KB, SK>(PX0, PX1, K_lds, r32, hi, S.qr, ACT(t));                                             \
        finishSM(PY0, PY1, alY, l_reg, pa0, pa1, pa2, pa3); SBAR();                                                           \
        if ((t) + 1 < NT) { if constexpr (F32) { VMW(); SWRITE_KF(SB); SBAR(); SLOAD_F((const float*)Vh, KBASE((t) + 1)); }  \
                            else { SLOAD_H(Kh, Vh, KBASE((t) + 1)); } SBAR(); }                                               \
        pv_tile<VB, SK>(o, vb0, pa0, pa1, pa2, pa3, ACT((t) - 1)); MASKT(PX0, PX1, (t)); partialSM(PX0, PX1, m_reg, mnX, alX, keepT);                                        \
        __syncthreads();                                                                                                      \
        if ((t) + 1 < NT) { VMW(); if constexpr (F32) { SWRITE_VF(SB); SBAR(); if ((t) + 2 < NT) SLOAD_F((const float*)Kh, KBASE((t) + 2)); } \
                            else { SWRITE_H(SB); } }                                                                          \
        RESC(alX); __syncthreads(); } while (0)
    for (int t = 1; t + 1 < NT; t += 2) {
        HALF_STEP(pB0, pB1, mnB, alB, pA0, pA1, alA, t, 1, 0, 0);
        HALF_STEP(pA0, pA1, mnA, alA, pB0, pB1, alB, t + 1, 0, 1, 1);
    }
    const bool even = (NT & 1) == 0;
    if (even) { SBAR(); qkt<1, SK>(pB0, pB1, K_lds, r32, hi, S.qr, ACT(NT - 1)); SBAR(); }
#define QROW(e) (nxt.Q + (size_t)(wid * QBLK + r32) * D + ((e) >> 1) * 16 + hi * 8 + ((e) & 1) * 4)
    if constexpr (F32) { SLOAD_F((const float*)nxt.K, kbn); SBAR();
#pragma unroll
        for (int e = 0; e < 8; ++e) S.tq[e] = *(const f32x4*)QROW(e); }
    else { int sr_ = sr, sc_ = sc; asm volatile("" : "+v"(sr_), "+v"(sc_)); { const int sr = sr_, sc = sc_; SLOAD_H(nxt.K, nxt.V, kbn); } SBAR();
#pragma unroll
        for (int d0 = 0; d0 < 8; ++d0) S.qr[d0] = load8<TIn>(nxt.Q + (size_t)(wid * QBLK + r32) * D + d0 * 16 + hi * 8); }
    SBAR();
    finishSM(pA0, pA1, alA, l_reg, pa0, pa1, pa2, pa3); SBAR();
    if constexpr (F32) {
#pragma unroll
        for (int e = 8; e < 16; ++e) S.tq[e] = *(const f32x4*)QROW(e); SBAR(); }
#undef QROW
    pv_tile<0, SK>(o, vb0, pa0, pa1, pa2, pa3, ACT(even ? NT - 2 : NT - 1));
    if (even) { MASKT(pB0, pB1, NT - 1); partialSM(pB0, pB1, m_reg, mnB, alB, keepT); __syncthreads(); RESC(alB);
        finishSM(pB0, pB1, alB, l_reg, pa0, pa1, pa2, pa3); SBAR(); pv_tile<1, SK>(o, vb0, pa0, pa1, pa2, pa3, ACT(NT - 1)); }
    SBAR(); SEAM_K0();
    if (hi == 0) li_l[r32] = l_reg; asm volatile("s_waitcnt lgkmcnt(0)" ::: "memory");
    float rli[16];
#pragma unroll
    for (int r = 0; r < 16; ++r) rli[r] = __builtin_amdgcn_rcpf(li_l[crow(r, hi)]);
    unsigned char* Ow8 = (unsigned char*)cur.O + (size_t)(wid * QBLK) * OSTR;
#pragma unroll
    for (int r = 0; r < 16; ++r) { const int orow = crow(r, hi);
#pragma unroll
        for (int d0 = 0; d0 < 4; ++d0) { const float v = o[d0][r] * rli[r];
            const float v64 = v * 64.0f, vb = __shfl_xor(v64, 1), vc = __shfl_xor(v64, 2), vd = __shfl_xor(vb, 2);
            if ((r32 & 3) == 0) *(unsigned*)(Ow8 + (size_t)orow * OSTR + d0 * 32 + r32) = pk4_fp8(v64, vb, vc, vd); } }
    if constexpr (F32) {
#pragma unroll
        for (int d0 = 0; d0 < 8; ++d0) S.qr[d0] = pack8(S.tq[2 * d0], S.tq[2 * d0 + 1]); }
    __syncthreads();
#undef RESC
#undef KBASE
#undef ACT
#undef MASKT
#undef SEAM_K0
#undef HALF_STEP
}
#undef ROW
#undef VMW
#undef VMWN
#undef SLOAD_H
#undef SWRITE_HK
#undef SWRITE_HV
#undef SWRITE_H
#undef SLOAD_F
#undef SWRITE_KF
#undef SWRITE_VF

#undef KSWZ
#undef SBAR
}

__device__ __forceinline__ void attn_phase(Frame& F) {
    if (F.bid >= 144) return;
    typedef att::BlockRef<bf16, bf16> Ref;
    const int bh = F.bid & 15, y = F.bid >> 4, b = bh >> 3, h = bh & 7;
    const bf16* MQ = wsp<bf16>(F, WS_MQ) + (size_t)bh * 4096 * 128; const bf16* MK = wsp<bf16>(F, WS_MK) + (size_t)bh * 4096 * 128; const bf16* MV = wsp<bf16>(F, WS_MV) + (size_t)bh * 4096 * 128;
    bf16* OA = (bf16*)(F.ws + WS_OA + (size_t)b * 4096 * 1024 + h * 128);        const float* KM = wsp<float>(F, OFF_KMEAN) + (size_t)bh * 16 * 128;
    const bool single = (y == 0) || (y == 8); const int q0 = y == 0 ? 15 : (y == 8 ? 7 : y - 1), q1 = single ? q0 : 15 - y;
    const Ref r0{MQ + (size_t)q0 * 256 * 128, MK, MV, (bf16*)((unsigned char*)OA + (size_t)q0 * 256 * 1024), q0 * 256, KM};
    const Ref r1{MQ + (size_t)q1 * 256 * 128, MK, MV, (bf16*)((unsigned char*)OA + (size_t)q1 * 256 * 1024), q1 * 256, KM};
    att::Seam<bf16> S;
    char* lds = (char*)F.ldsg;
    ((LAS f32x4*)(F.lds + att::LDS_BYTES + 4096))[F.tid] = ((const GAS f32x4*)KM)[F.tid] + ((const GAS f32x4*)(wsp<float>(F, WS_KMEAN1) + (size_t)bh * 16 * 128))[F.tid];
    __syncthreads();
    att::causal_swa_prime<bf16, bf16>(r0, 1 << 30, lds, S);
    att::causal_swa_block<bf16, bf16>(r0, r1, 4096, 1 << 30, lds, S);
    if (!single) att::causal_swa_block<bf16, bf16>(r1, r1, 4096, 1 << 30, lds, S);
    VM_WAIT(); __syncthreads();
}


namespace ret {
constexpr int PITCH = 272, TILE = 128 * PITCH;
constexpr int QS = 0, KS = TILE, PS = 2 * TILE, ST = 3 * TILE, YT = 0, YPITCH = 528;
static_assert(128 * YPITCH <= 2 * TILE && ST + 8192 <= RING_BYTES, "retention LDS map");
typedef short s16x4 __attribute__((ext_vector_type(4)));
typedef short v4i16_t __attribute__((ext_vector_type(4)));
__device__ __forceinline__ s16x4 vtr(LAS const unsigned char* p) { return __builtin_bit_cast(s16x4, __builtin_amdgcn_ds_read_tr16_b64_v4i16((LAS v4i16_t*)p)); }
#define RMFMA(a, b, c) __builtin_amdgcn_mfma_f32_32x32x16_bf16((a), (b), (c), 0, 0, 0)
__device__ __forceinline__ bf16x8 pack_step(const f32x16& x, int s) {
    u32x4 w; w.x = pk2(x[8 * s], x[8 * s + 1]); w.y = pk2(x[8 * s + 2], x[8 * s + 3]); w.z = pk2(x[8 * s + 4], x[8 * s + 5]); w.w = pk2(x[8 * s + 6], x[8 * s + 7]);
    return __builtin_bit_cast(bf16x8, w);
}
__device__ __forceinline__ void retention_item(Frame& F, const Args& A, int bh, int seg) {
    LAS unsigned char* lds = F.lds;
    const int tid = F.tid, lane = F.lane, w = F.wave, r = lane & 31, h = lane >> 5;
    const int head = bh & 7, b = bh >> 3;
    const bf16* RQ = wsp<bf16>(F, WS_RQ) + (size_t)bh * 4096 * 128; const bf16* RK = wsp<bf16>(F, WS_RK) + (size_t)bh * 4096 * 128;
    const bf16* RVT = wsp<bf16>(F, WS_RVT) + ((size_t)bh * 256 + 32 * w + r) * 4096 + 8 * h;
    const bf16* RG = wsp<bf16>(F, WS_RG); bf16* YR = wsp<bf16>(F, WS_YR);
    const float nlg = -log2f(1.0f - exp2f(-(5.0f + (float)head)));
    const float cd = exp2f(-128.0f * nlg);
    f32x16 R[4];
#pragma unroll
    for (int d = 0; d < 4; ++d)
#pragma unroll
        for (int i = 0; i < 16; ++i) R[d][i] = 0.f;
    const int n0 = seg == 0 ? 0 : (seg == 1 ? 11 : (seg == 2 ? 20 : 27)), nend = seg == 0 ? 11 : (seg == 1 ? 20 : (seg == 2 ? 27 : 32));
    u32x4 stq[4], stk[4];
    const int srow = tid >> 4, sch = tid & 15;
    const unsigned swr = (unsigned)(srow * PITCH + sch * 16);
#define RLOADK(n) do { _Pragma("unroll") for (int k_ = 0; k_ < 4; ++k_) stk[k_] = *(const GAS u32x4*)(RK + ((size_t)(n) * 128 + srow + 32 * k_) * 128 + sch * 8); } while (0)
#define RLOADQ(n) do { _Pragma("unroll") for (int k_ = 0; k_ < 4; ++k_) stq[k_] = __builtin_nontemporal_load((const GAS u32x4*)(RQ + ((size_t)(n) * 128 + srow + 32 * k_) * 128 + sch * 8)); } while (0)
#define RWRITEK() do { _Pragma("unroll") for (int k_ = 0; k_ < 4; ++k_) *(LAS u32x4*)(lds + KS + swr + k_ * 32 * PITCH) = stk[k_]; } while (0)
#define RWRITEQ() do { _Pragma("unroll") for (int k_ = 0; k_ < 4; ++k_) *(LAS u32x4*)(lds + QS + swr + k_ * 32 * PITCH) = stq[k_]; } while (0)
    RLOADK(0); if (n0 == 0) RLOADQ(0);
    RWRITEK(); if (n0 == 0) RWRITEQ();
    __syncthreads();
    const int d8 = tid & 31; f32x4 gw0, gw1;
    { const GAS f32x4* gp = (const GAS f32x4*)(A.in[I_GN_W] + head * 256 + d8 * 8); gw0 = gp[0]; gw1 = gp[1]; }
    const unsigned nat = (unsigned)(r * PITCH + h * 16), prm = (unsigned)(r * PITCH + h * 8);
    const unsigned trb = (unsigned)((8 * h + ((lane & 15) >> 2)) * PITCH + ((lane >> 4) & 1) * 32 + (lane & 3) * 8);
#define RVLOAD(n) do { _Pragma("unroll") for (int ks = 0; ks < 8; ++ks) vfr[ks] = *(const GAS bf16x8*)(RVT + (size_t)(n) * 128 + ks * 16); } while (0)
#define RUPDATE() do { _Pragma("unroll") for (int d = 0; d < 4; ++d) { \
            _Pragma("unroll") for (int ks = 0; ks < 8; ++ks) { LAS const unsigned char* kp = lds + KS + trb + ks * 16 * PITCH + d * 64; \
                const s16x4 lo = vtr(kp); const s16x4 hi4 = vtr(kp + 4 * PITCH); \
                const bf16x8 ka = __builtin_shufflevector(lo, hi4, 0, 1, 2, 3, 4, 5, 6, 7); \
                R[d] = RMFMA(ka, vfr[ks], R[d]); if ((ks & 3) == 3) __builtin_amdgcn_sched_barrier(0); } \
            _Pragma("unroll") for (int i = 0; i < 16; ++i) R[d][i] *= cd; \
            __builtin_amdgcn_sched_barrier(0); } } while (0)
    for (int n = 0; n < n0; ++n) {
        bf16x8 vfr[8]; RVLOAD(n);
        RUPDATE();
        __builtin_amdgcn_sched_barrier(0);
        RLOADK(n + 1); if (n + 1 == n0) RLOADQ(n + 1);
        __syncthreads();
        RWRITEK(); if (n + 1 == n0) RWRITEQ();
        __syncthreads();
    }
    for (int n = n0; n < nend; ++n) {
        const bool has_next = (n + 1) < nend;
        bf16x8 vfr[8]; RVLOAD(n);
        f32x16 O[4];
        {
            const int it = w >> 1;
#pragma unroll
            for (int jj = 0; jj < 2; ++jj) { const int jt = 2 * (w & 1) + jj;
                if (jt <= it) {
                    f32x16 x;
#pragma unroll
                    for (int i = 0; i < 16; ++i) x[i] = 0.f;
                    LAS const unsigned char* ka = lds + KS + nat + jt * 32 * PITCH; LAS const unsigned char* qa = lds + QS + nat + it * 32 * PITCH;
#pragma unroll
                    for (int s = 0; s < 8; ++s) { const bf16x8 a = *(const LAS bf16x8*)(ka + s * 32); const bf16x8 bq = *(const LAS bf16x8*)(qa + s * 32); x = RMFMA(a, bq, x); }
                    if (jt == it) {
#pragma unroll
                        for (int i = 0; i < 16; ++i) { const int jl = (i & 3) + 8 * (i >> 2) + 4 * h; x[i] = jl <= r ? x[i] : 0.f; } }
                    LAS unsigned char* pw = lds + PS + prm + it * 32 * PITCH + jt * 64;
#pragma unroll
                    for (int g = 0; g < 4; ++g) { u32x2 v; v.x = pk2(x[4 * g], x[4 * g + 1]); v.y = pk2(x[4 * g + 2], x[4 * g + 3]); *(LAS u32x2*)(pw + g * 16) = v; }
                } }
            __syncthreads();
#pragma unroll
            for (int t = 0; t < 4; ++t)
#pragma unroll
                for (int i = 0; i < 16; ++i) O[t][i] = 0.f;
#pragma unroll
            for (int t = 0; t < 4; ++t)
#pragma unroll
                for (int kx = 0; kx < 8; ++kx) if (kx < 2 * t + 2) { const bf16x8 pb = *(const LAS bf16x8*)(lds + PS + nat + t * 32 * PITCH + kx * 32); O[t] = RMFMA(vfr[kx], pb, O[t]); if (kx & 1) __builtin_amdgcn_sched_barrier(0); }
#pragma unroll
            for (int d = 0; d < 4; ++d)
#pragma unroll
                for (int s = 0; s < 2; ++s) { const bf16x8 ra = pack_step(R[d], s);
#pragma unroll
                    for (int t = 0; t < 4; ++t) { LAS const unsigned char* qp = lds + QS + prm + t * 32 * PITCH + d * 64 + s * 32; const u32x2 lo = *(const LAS u32x2*)qp, hi2 = *(const LAS u32x2*)(qp + 16);
                        u32x4 qb; qb.x = lo.x; qb.y = lo.y; qb.z = hi2.x; qb.w = hi2.y; O[t] = RMFMA(ra, __builtin_bit_cast(bf16x8, qb), O[t]); }
                    __builtin_amdgcn_sched_barrier(0); }
        }
        RUPDATE();
        __builtin_amdgcn_sched_barrier(0);
        if (has_next) { RLOADK(n + 1); RLOADQ(n + 1); }
        {
            LAS float* st = (LAS float*)(lds + ST);
#pragma unroll
            for (int t = 0; t < 4; ++t) { const float sc = exp2f(-(float)(32 * t + r + 1) * nlg); float s1 = 0.f, s2 = 0.f;
#pragma unroll
                for (int i = 0; i < 16; ++i) { O[t][i] *= sc; s1 += O[t][i]; s2 = fmaf(O[t][i], O[t][i], s2); }
                s1 += __shfl_xor(s1, 32); s2 += __shfl_xor(s2, 32);
                if (h == 0) { st[(w * 128 + 32 * t + r) * 2] = s1; st[(w * 128 + 32 * t + r) * 2 + 1] = s2; } }
        }
        __syncthreads();
        {
            const LAS float* st = (const LAS float*)(lds + ST);
#pragma unroll
            for (int t = 0; t < 4; ++t) { float s1 = 0.f, s2 = 0.f;
#pragma unroll
                for (int ww = 0; ww < 8; ++ww) { s1 += st[(ww * 128 + 32 * t + r) * 2]; s2 += st[(ww * 128 + 32 * t + r) * 2 + 1]; }
                const float mu = s1 * (1.0f / 256.0f), var = fmaxf(s2 * (1.0f / 256.0f) - mu * mu, 0.f), rstd = 1.0f / sqrtf(var + GN_EPS);
                LAS unsigned char* yw = lds + YT + (32 * t + r) * YPITCH + (32 * w + 4 * h) * 2;
#pragma unroll
                for (int g = 0; g < 4; ++g) { u32x2 v; v.x = pk2((O[t][4 * g] - mu) * rstd, (O[t][4 * g + 1] - mu) * rstd); v.y = pk2((O[t][4 * g + 2] - mu) * rstd, (O[t][4 * g + 3] - mu) * rstd);
                    *(LAS u32x2*)(yw + g * 16) = v; } }
            __syncthreads();
            const size_t tok0 = (size_t)b * 4096 + (size_t)n * 128;
#pragma unroll
            for (int k_ = 0; k_ < 8; ++k_) { const int tl = (tid >> 5) + 16 * k_; const u32x4 y = *(const LAS u32x4*)(lds + YT + tl * YPITCH + d8 * 16);
                const size_t go = (tok0 + tl) * 2048 + head * 256 + d8 * 8; const u32x4 g = __builtin_nontemporal_load((const GAS u32x4*)(RG + go));
                f32x4 o0, o1; o0.x = bf_lo(y.x) * gw0.x * bf_lo(g.x); o0.y = bf_hi(y.x) * gw0.y * bf_hi(g.x); o0.z = bf_lo(y.y) * gw0.z * bf_lo(g.y); o0.w = bf_hi(y.y) * gw0.w * bf_hi(g.y);
                o1.x = bf_lo(y.z) * gw1.x * bf_lo(g.z); o1.y = bf_hi(y.z) * gw1.y * bf_hi(g.z); o1.z = bf_lo(y.w) * gw1.z * bf_lo(g.w); o1.w = bf_hi(y.w) * gw1.w * bf_hi(g.w);
                { u32x2 y8;
#define Y8C(v_) __builtin_amdgcn_fmed3f((v_) * 8.0f, -448.0f, 448.0f)
                  y8.x = pk4_fp8(Y8C(o0.x), Y8C(o0.y), Y8C(o0.z), Y8C(o0.w)); y8.y = pk4_fp8(Y8C(o1.x), Y8C(o1.y), Y8C(o1.z), Y8C(o1.w));
#undef Y8C
                  *(GAS u32x2*)((unsigned char*)YR + go) = y8; } }
            __syncthreads();
        }
        if (has_next) { RWRITEK(); RWRITEQ(); }
        __syncthreads();
    }
#undef RVLOAD
#undef RUPDATE
#undef RLOADK
#undef RLOADQ
#undef RWRITEK
#undef RWRITEQ
}
#undef RMFMA
}
__device__ __forceinline__ void retention_phase(Frame& F, const Args& A) {
    if (F.bid < 144 || F.bid >= 208) return;
    const int idx = F.bid - 144;
    ret::retention_item(F, A, idx & 15, idx >> 4);
}

struct SchedDense {
    static constexpr bool GATHER = false, LITE = false;
    int G, c; const char* ws; unsigned offA, offW, ts;
    __device__ __forceinline__ bool next(int i, Unit& u) const { const int L = i * G + c; if (L >= 256) return false; int pm, pn; pg8::tile_of(L, 32, 8, pm, pn); u.pm = pm; u.pn = pn; u.kind = 0; u.aux = 0; u.slot = i; return true; }
    __device__ __forceinline__ void ptrs(const Unit& u, unsigned& a, unsigned& b) const { a = offA + (unsigned)u.pm * ts; b = offW + (unsigned)u.pn * ts; }
    __device__ __forceinline__ int arow(int, int) const { return 0; }
};
struct EpiMixA {
    unsigned char* ws;
    __device__ __forceinline__ void operator()(AccRef acc, const Unit& u, int wr, int wc, int fr, int fq) const {
        asm volatile("" : "+v"(fr), "+v"(fq));
        const unsigned char* GA = ws + WS_GA; unsigned char* MIXA = ws + WS_MIXA;
#pragma unroll
        for (int ai = 0; ai < 2; ++ai)
#pragma unroll
            for (int m = 0; m < 4; ++m) { const size_t off = (size_t)(u.pm * 256 + ai * 128 + wr * 64 + m * 16 + fr) * 2048 + u.pn * 256 + wc * 64 + 16 * fq;
                const u32x4 g = *(const GAS u32x4*)(GA + off); u32x4 o;
#pragma unroll
                for (int bj = 0; bj < 2; ++bj) { const f32x4 g0 = unpk4_fp8(bj ? g.z : g.x), g1 = unpk4_fp8(bj ? g.w : g.y);
                    const f32x4 v0 = acc[ai][bj][m][0] * (1.0f / 32.0f) * g0, v1 = acc[ai][bj][m][1] * (1.0f / 32.0f) * g1;
                    const unsigned p0 = pk4_fp8(v0.x, v0.y, v0.z, v0.w), p1 = pk4_fp8(v1.x, v1.y, v1.z, v1.w);
                    if (bj) { o.z = p0; o.w = p1; } else { o.x = p0; o.y = p1; } }
                *(GAS u32x4*)(MIXA + off) = o; }
    }
};
constexpr float MIX_SCALE = 64.0f;
struct EpiMixB {
    unsigned char* ws;
    __device__ __forceinline__ void operator()(AccRef acc, const Unit& u, int wr, int wc, int fr, int fq) const {
        asm volatile("" : "+v"(fr), "+v"(fq));
        const bf16* GR = (const bf16*)(ws + WS_GR); const unsigned char* MIXA = ws + WS_MIXA; unsigned char* MIX = ws + WS_MIX;
#pragma unroll
        for (int ai = 0; ai < 2; ++ai)
#pragma unroll
            for (int m = 0; m < 4; ++m) { const size_t off = (size_t)(u.pm * 256 + ai * 128 + wr * 64 + m * 16 + fr) * 2048 + u.pn * 256 + wc * 64 + 16 * fq;
                const u32x4 a8 = *(const GAS u32x4*)(MIXA + off); u32x4 o;
#pragma unroll
                for (int bj = 0; bj < 2; ++bj) { const u32x4 g = *(const GAS u32x4*)(GR + off + bj * 8); const f32x4 a0 = unpk4_fp8(bj ? a8.z : a8.x) * (1.0f / 64.0f), a1 = unpk4_fp8(bj ? a8.w : a8.y) * (1.0f / 64.0f); f32x4 v0 = acc[ai][bj][m][0] * (1.0f / 256.0f), v1 = acc[ai][bj][m][1] * (1.0f / 256.0f);
                    v0.x = fmaf(v0.x, bf_lo(g.x), a0.x); v0.y = fmaf(v0.y, bf_hi(g.x), a0.y); v0.z = fmaf(v0.z, bf_lo(g.y), a0.z); v0.w = fmaf(v0.w, bf_hi(g.y), a0.w);
                    v1.x = fmaf(v1.x, bf_lo(g.z), a1.x); v1.y = fmaf(v1.y, bf_hi(g.z), a1.y); v1.z = fmaf(v1.z, bf_lo(g.w), a1.z); v1.w = fmaf(v1.w, bf_hi(g.w), a1.w);
#pragma unroll
                    for (int j = 0; j < 4; ++j) { v0[j] = __builtin_amdgcn_fmed3f(v0[j] * MIX_SCALE, -127.0f, 127.0f); v1[j] = __builtin_amdgcn_fmed3f(v1[j] * MIX_SCALE, -127.0f, 127.0f); }
                    const unsigned p0 = pk4_i8(v0.x, v0.y, v0.z, v0.w), p1 = pk4_i8(v1.x, v1.y, v1.z, v1.w); if (bj) { o.z = p0; o.w = p1; } else { o.x = p0; o.y = p1; } }
                *(GAS u32x4*)(MIX + off) = o; }
    }
};
struct EpiOut {
    const float* X; unsigned char* ws; bool skip_at;
    __device__ __forceinline__ void operator()(AccRef acc, const Unit& u, int wr, int wc, int fr, int fq) const {
        asm volatile("" : "+v"(fr), "+v"(fq));
        bf16* X1B = (bf16*)(ws + WS_X1B); float* SSQP = (float*)(ws + WS_SSQP);
#pragma unroll
        for (int ai = 0; ai < 2; ++ai)
#pragma unroll
            for (int m = 0; m < 4; ++m) { const int row = u.pm * 256 + ai * 128 + wr * 64 + m * 16 + fr; const size_t off = (size_t)row * 2048 + u.pn * 256 + wc * 32 + 8 * fq; float ss = 0.f;
#pragma unroll
                for (int bj = 0; bj < 2; ++bj) { const f32x4 x0 = *(const GAS f32x4*)(X + off + bj * 128), x1 = *(const GAS f32x4*)(X + off + bj * 128 + 4);
                    const f32x4 v0 = acc[ai][bj][m][0] * (1.0f / (MIX_SCALE * W_IN_SCALE)) + x0, v1 = acc[ai][bj][m][1] * (1.0f / (MIX_SCALE * W_IN_SCALE)) + x1;
                    *(GAS u32x4*)(X1B + off + bj * 128) = pack8(v0, v1);
                    { u32x2 o8; o8.x = pk4_fp8(v0.x, v0.y, v0.z, v0.w); o8.y = pk4_fp8(v1.x, v1.y, v1.z, v1.w); *(GAS u32x2*)(ws + WS_X1B8 + off + bj * 128) = o8; }
                    ss += (v0.x * v0.x + v0.y * v0.y) + (v0.z * v0.z + v0.w * v0.w) + (v1.x * v1.x + v1.y * v1.y) + (v1.z * v1.z + v1.w * v1.w); }
                ss += __shfl_xor(ss, 16); ss += __shfl_xor(ss, 32);
                if (fq == 0) SSQP[(size_t)(u.pn * 4 + wc) * 8192 + row] = ss; }
    }
};

__device__ __forceinline__ void router_phase(Frame& F, const Args& A) {
    const bf16* X1B = wsp<bf16>(F, WS_X1B); const bf16* WRT = wsp<bf16>(F, WS_WRT); const float* SSQP = wsp<float>(F, WS_SSQP);
    unsigned* CNT = wsp<unsigned>(F, OFF_CNT); unsigned* LISTTOK = wsp<unsigned>(F, WS_LISTTOK); float* LISTW = wsp<float>(F, WS_LISTW); float* RSTD = wsp<float>(F, WS_RSTD);
    LAS float* part = (LAS float*)F.lds;
    LAS float* logit = (LAS float*)(F.lds + 65536);
    LAS float* ssl = (LAS float*)(F.lds + 65536 + 8192);
    const int lane = F.lane, w = F.wave, r32 = lane & 31, hi = lane >> 5;
    for (int rt = F.bid; rt < T / 32; rt += F.G) {
        const int row0 = rt * 32;
        f32x16 a0, a1;
#pragma unroll
        for (int i = 0; i < 16; ++i) { a0[i] = 0.f; a1[i] = 0.f; }
        const bf16* ap = X1B + (size_t)(row0 + r32) * 2048 + w * 256 + hi * 8; const bf16* bp0 = WRT + (size_t)r32 * 2048 + w * 256 + hi * 8; const bf16* bp1 = bp0 + (size_t)32 * 2048;
#pragma unroll 8
        for (int ks = 0; ks < 16; ++ks) { const bf16x8 a = *(const GAS bf16x8*)(ap + ks * 16), b0 = *(const GAS bf16x8*)(bp0 + ks * 16), b1 = *(const GAS bf16x8*)(bp1 + ks * 16);
            a0 = __builtin_amdgcn_mfma_f32_32x32x16_bf16(a, b0, a0, 0, 0, 0); a1 = __builtin_amdgcn_mfma_f32_32x32x16_bf16(a, b1, a1, 0, 0, 0); }
#pragma unroll
        for (int i = 0; i < 16; ++i) { const int row = (i & 3) + 8 * (i >> 2) + 4 * hi; part[(w * 32 + row) * 64 + r32] = a0[i]; part[(w * 32 + row) * 64 + 32 + r32] = a1[i]; }
        { const int tk = F.tid & 31, pp = F.tid >> 5; ssl[pp * 32 + tk] = SSQP[(size_t)pp * 8192 + row0 + tk] + SSQP[(size_t)(pp + 16) * 8192 + row0 + tk]; }
        __syncthreads();
        for (int e = F.tid; e < 2048; e += 512) { float s = 0.f;
#pragma unroll
            for (int ww = 0; ww < 8; ++ww) s += part[ww * 2048 + e];
            logit[e] = s; }
        __syncthreads();
        if (F.tid < 32) {
            const int t = row0 + F.tid; const LAS float* lg = logit + F.tid * 64;
            float ssq = 0.f;
#pragma unroll
            for (int pp = 0; pp < 16; ++pp) ssq += ssl[pp * 32 + F.tid];
            const float rstd = 1.0f / sqrtf(ssq * (1.0f / DM) + RMS_EPS);
            float gl[4]; float gm = -__builtin_inff(); int gi = 0;
#pragma unroll
            for (int j = 0; j < 4; ++j) { gl[j] = lg[j] * rstd + A.in[I_B_RG][j]; if (gl[j] > gm) { gm = gl[j]; gi = j; } }
            float gs = 0.f;
#pragma unroll
            for (int j = 0; j < 4; ++j) gs += __expf(gl[j] - gm);
            const float gw = 1.0f / gs;
            float el[8]; float em = -__builtin_inff();
#pragma unroll
            for (int j = 0; j < 8; ++j) { el[j] = lg[4 + gi * 8 + j] * rstd + A.in[I_B_RE][gi * 8 + j]; em = fmaxf(em, el[j]); }
            int i1 = 0; float p1 = -1.f;
#pragma unroll
            for (int j = 0; j < 8; ++j) { el[j] = __expf(el[j] - em); if (el[j] > p1) { p1 = el[j]; i1 = j; } }
            int i2 = 0; float p2 = -1.f;
#pragma unroll
            for (int j = 0; j < 8; ++j) if (j != i1 && el[j] > p2) { p2 = el[j]; i2 = j; }
            const float inv = 1.0f / (p1 + p2);
            const int e1 = gi * 8 + i1, e2 = gi * 8 + i2;
            LAS unsigned* cl = (LAS unsigned*)(F.lds + MISC_OFF + 2304);
            volatile LAS unsigned* clv = cl;
            clv[F.tid] = 0u; __builtin_amdgcn_wave_barrier();
            const unsigned r1 = __hip_atomic_fetch_add(cl + e1, 1u, __ATOMIC_RELAXED, __HIP_MEMORY_SCOPE_WORKGROUP), r2 = __hip_atomic_fetch_add(cl + e2, 1u, __ATOMIC_RELAXED, __HIP_MEMORY_SCOPE_WORKGROUP);
            __builtin_amdgcn_wave_barrier();
            { const unsigned c_ = clv[F.tid]; clv[32 + F.tid] = c_ ? atomicAdd(CNT + (rt & 15) * 32 + F.tid, c_) : 0u; }
            __builtin_amdgcn_wave_barrier();
            const unsigned q1 = (unsigned)(rt & 15) * 512u + clv[32 + e1] + r1, q2 = (unsigned)(rt & 15) * 512u + clv[32 + e2] + r2;
            LISTTOK[e1 * 8192 + q1] = (unsigned)t; LISTW[e1 * 8192 + q1] = gw * p1 * inv;
            LISTTOK[e2 * 8192 + q2] = (unsigned)t | 0x10000u; LISTW[e2 * 8192 + q2] = gw * p2 * inv;
            RSTD[t] = rstd;
        }
        __syncthreads();
    }
}

constexpr int PRE_OFF = MISC_OFF + 10240;
__device__ __forceinline__ void build_tables(Frame& F) {
    LAS int* tb = (LAS int*)(F.lds + MISC_OFF); LAS int* cg = (LAS int*)(F.lds + PRE_OFF); LAS int* pre = cg + 512;
    { const unsigned* CNT = wsp<unsigned>(F, OFF_CNT); cg[(F.tid & 31) * 16 + (F.tid >> 5)] = (int)__hip_atomic_load(CNT + F.tid, __ATOMIC_RELAXED, __HIP_MEMORY_SCOPE_AGENT); }
    __syncthreads();
    if (F.tid < 64) { const int e = F.tid & 31; int c = 0;
#pragma unroll
        for (int g = 0; g < 16; ++g) { if (F.tid < 32) pre[e * 16 + g] = c; c += cg[e * 16 + g]; }
        const int pc = (c + 255) & ~255;
        int incl = pc;
#pragma unroll
        for (int o = 1; o < 32; o <<= 1) { const int t = __shfl_up(incl, o, 32); if (e >= o) incl += t; }
        const int rem = c & 255, lt = (rem != 0 && rem <= 128) ? 1 : 0, fl = (pc >> 8) - lt; int fi = fl, li = lt;
#pragma unroll
        for (int o = 1; o < 32; o <<= 1) { const int t1 = __shfl_up(fi, o, 32), t2 = __shfl_up(li, o, 32); if (e >= o) { fi += t1; li += t2; } }
        if (F.tid < 32) { tb[e] = c; tb[32 + e] = incl - pc; tb[72 + e] = fi - fl; tb[112 + e] = li - lt; if (e == 31) { tb[64] = incl; tb[104] = fi; tb[144] = li; } } }
    __syncthreads();
}
__device__ __forceinline__ int list_pos(const LAS int* pre, int e, int idx) {
    int g = 0;
#pragma unroll
    for (int k = 1; k < 16; ++k) if (idx >= pre[e * 16 + k]) g = k;
    return e * 8192 + g * 512 + (idx - pre[e * 16 + g]);
}
constexpr int TOKT_OFF = MISC_OFF + 4096, TOKT_UNITS = 6;
template <bool GATH> struct SchedExpert {
    static constexpr bool GATHER = GATH, LITE = GATH;
    int G, c, NT; const char* ws; unsigned offA, offW, tsA, tsW; int wtiles_per_e; const LAS int* tb; const LAS int* tokt;
    __device__ __forceinline__ bool next(int i, Unit& u) const {
        if constexpr (!GATH) {
            const int nF = tb[104] * NT, nL = tb[144] * NT; int L = i * G + c; if (L >= nF + nL) return false;
            const int lite = L >= nF ? 1 : 0, n = lite ? nL : nF; if (lite) L -= nF;
            { const int q = n / 8, r = n % 8, xcd = L % 8, off = L / 8; L = (xcd < r ? xcd * (q + 1) : r * (q + 1) + (xcd - r) * q) + off; }
            const LAS int* P = tb + (lite ? 112 : 72);
            int e = 0;
            for (int k = 1; k < 32; ++k) if (L >= P[k] * NT) e = k;
            const int q = L - P[e] * NT, fe = tb[72 + e + 1] - tb[72 + e];
            if (lite) { u.aux = fe; u.pn = q; } else { u.aux = q % fe; u.pn = q / fe; }
            u.pm = (tb[32 + e] >> 8) + u.aux; u.kind = e; u.slot = i; u.lite = lite; return true;
        }
        const int total = (tb[64] >> 8) * NT; int L = i * G + c; if (L >= total) return false;
        { const int q = total / 8, r = total % 8, xcd = L % 8, off = L / 8; L = (xcd < r ? xcd * (q + 1) : r * (q + 1) + (xcd - r) * q) + off; }
        int e = 0;
        for (int k = 1; k < 32; ++k) if (L >= (tb[32 + k] >> 8) * NT) e = k;
        const int mt = (tb[32 + e + 1] - tb[32 + e]) >> 8, q = L - (tb[32 + e] >> 8) * NT;
        u.aux = q % mt; u.pm = (tb[32 + e] >> 8) + u.aux; u.pn = q / mt; u.kind = e; u.slot = i; u.lite = (tb[e] - u.aux * 256 <= 128) ? 1 : 0; return true;
    }
    __device__ __forceinline__ void ptrs(const Unit& u, unsigned& a, unsigned& b) const { a = GATH ? offA : offA + (unsigned)u.pm * tsA; b = offW + (unsigned)(u.kind * wtiles_per_e + u.pn) * tsW; }
    __device__ __forceinline__ int arow(int slot, int row) const { return GATH ? tokt[slot * 256 + row] : 0; }
};
__device__ __forceinline__ void fill_unit_tokens(Frame& F, const SchedExpert<true>& S) {
    LAS int* tokt = (LAS int*)(F.lds + TOKT_OFF); const LAS int* tb = (const LAS int*)(F.lds + MISC_OFF); const unsigned* LISTTOK = wsp<unsigned>(F, WS_LISTTOK);
    Unit u;
    for (int i = 0; i < TOKT_UNITS && S.next(i, u); ++i)
        if (F.tid < 256) { const int idx = u.aux * 256 + F.tid; int tok = 0;
            if (idx < tb[u.kind]) { const int pos = list_pos((const LAS int*)(F.lds + PRE_OFF) + 512, u.kind, idx); const unsigned ent = LISTTOK[pos]; tok = (int)(ent & 0xffffu);
                if (u.pn == 0) { wsp<unsigned>(F, WS_DLT)[u.kind * 8192 + idx] = ent; wsp<float>(F, WS_DLW)[u.kind * 8192 + idx] = wsp<float>(F, WS_LISTW)[pos]; } }
            tokt[i * 256 + F.tid] = tok; }
    __syncthreads();
}
struct EpiExp1 {
    unsigned char* ws; const LAS int* tokt;
    __device__ __forceinline__ void operator()(AccRef acc, const Unit& u, int wr, int wc, int fr, int fq) const {
        asm volatile("" : "+v"(fr), "+v"(fq));
        const float* RSTD = (const float*)(ws + WS_RSTD); unsigned char* ACT = ws + WS_ACT;
#pragma unroll
        for (int ai = 0; ai < 2; ++ai)
#pragma unroll
            for (int m = 0; m < 4; ++m) { if (ai == 1 && u.lite) continue;
                const int rl = ai * 128 + wr * 64 + m * 16 + fr; const float rs = RSTD[tokt[u.slot * 256 + rl]] * (1.0f / 64.0f);
                f32x4 o[2];
#pragma unroll
                for (int n = 0; n < 2; ++n)
#pragma unroll
                    for (int j = 0; j < 4; ++j) o[n][j] = siluf_(acc[ai][0][m][n][j] * rs) * (acc[ai][1][m][n][j] * rs);
                u32x2 o8; o8.x = pk4_fp8(o[0].x, o[0].y, o[0].z, o[0].w); o8.y = pk4_fp8(o[1].x, o[1].y, o[1].z, o[1].w);
                *(GAS u32x2*)(ACT + (size_t)(u.pm * 256 + rl) * 512 + u.pn * 128 + wc * 32 + 8 * fq) = o8; }
    }
};
struct EpiExp2 {
    unsigned char* ws; const LAS int* tb;
    __device__ __forceinline__ void operator()(AccRef acc, const Unit& u, int wr, int wc, int fr, int fq) const {
        asm volatile("" : "+v"(fr), "+v"(fq));
        const unsigned* LISTTOK = (const unsigned*)(ws + WS_DLT); const float* LISTW = (const float*)(ws + WS_DLW); unsigned char* Y = ws + WS_Y;
        const int cnt = tb[u.kind];
#pragma unroll
        for (int ai = 0; ai < 2; ++ai)
#pragma unroll
            for (int m = 0; m < 4; ++m) { const int idx = u.aux * 256 + ai * 128 + wr * 64 + m * 16 + fr;
                if (idx < cnt) { const unsigned ent = LISTTOK[u.kind * 8192 + idx]; const float w = LISTW[u.kind * 8192 + idx] * (16.0f / 32.0f); unsigned char* yp = Y + ((size_t)(ent >> 16) * T + (ent & 0xffffu)) * 2048 + u.pn * 256 + wc * 64 + 16 * fq; u32x4 o8;
#pragma unroll
                    for (int bj = 0; bj < 2; ++bj) { const f32x4 v0 = acc[ai][bj][m][0] * w, v1 = acc[ai][bj][m][1] * w; const unsigned p0 = pk4_fp8(v0.x, v0.y, v0.z, v0.w), p1 = pk4_fp8(v1.x, v1.y, v1.z, v1.w); if (bj) { o8.z = p0; o8.w = p1; } else { o8.x = p0; o8.y = p1; } }
                    *(GAS u32x4*)yp = o8; } }
    }
};
__device__ __forceinline__ void final_phase(Frame& F, const Args& A) {
    const bf16* X1B = wsp<bf16>(F, WS_X1B); const unsigned char* Y = F.ws + WS_Y;
    const int gw = F.bid * 8 + F.wave, NGW = F.G * 8, lane = F.lane;
    f32x4 w[8];
    { const GAS f32x4* wr = (const GAS f32x4*)A.in[I_NORM_FINAL] + lane;
#pragma unroll
      for (int j = 0; j < 8; ++j) w[j] = wr[64 * j]; }
    u32x2 xx[8]; unsigned ya[8], yb[8];
#define FIN_LOAD(m_) do { const GAS u32x2* xr = (const GAS u32x2*)(X1B + (size_t)(m_) * DM) + lane; const GAS unsigned* y0 = (const GAS unsigned*)(Y + (size_t)(m_) * DM) + lane; const GAS unsigned* y1 = (const GAS unsigned*)(Y + ((size_t)T + (m_)) * DM) + lane; \
        _Pragma("unroll") for (int j = 0; j < 8; ++j) { xx[j] = __builtin_nontemporal_load(xr + 64 * j); ya[j] = __builtin_nontemporal_load(y0 + 64 * j); yb[j] = __builtin_nontemporal_load(y1 + 64 * j); } } while (0)
    int m = gw; if (m >= T) return;
    FIN_LOAD(m);
    for (;;) {
        f32x4 v[8]; float s = 0.f;
#pragma unroll
        for (int j = 0; j < 8; ++j) { const f32x4 a = unpk4_fp8(ya[j]), b = unpk4_fp8(yb[j]);
            v[j].x = bf_lo(xx[j].x) + (a.x + b.x) * (1.0f / 16.0f); v[j].y = bf_hi(xx[j].x) + (a.y + b.y) * (1.0f / 16.0f); v[j].z = bf_lo(xx[j].y) + (a.z + b.z) * (1.0f / 16.0f); v[j].w = bf_hi(xx[j].y) + (a.w + b.w) * (1.0f / 16.0f);
            s += (v[j].x * v[j].x + v[j].y * v[j].y) + (v[j].z * v[j].z + v[j].w * v[j].w); }
        const int mn = m + NGW; const bool more = mn < T;
        if (more) FIN_LOAD(mn);
        const float rstd = 1.0f / sqrtf(wave_sum(s) * (1.0f / DM) + RMS_EPS);
        GAS f32x4* o = (GAS f32x4*)(A.out + (size_t)m * DM) + lane;
#pragma unroll
        for (int j = 0; j < 8; ++j) __builtin_nontemporal_store(v[j] * rstd * w[j], o + 64 * j);
        if (!more) break;
        m = mn;
    }
#undef FIN_LOAD
}

constexpr int NPHASE = 10;
__global__ void __launch_bounds__(512, 2) mk_fwd(Args args) {
    extern __shared__ __attribute__((aligned(16))) unsigned char lds_raw[];
    Frame F;
    F.lds = (LAS unsigned char*)lds_raw; F.ldsg = lds_raw; F.ws = args.ws;
    F.tid = threadIdx.x; F.lane = F.tid & 63; F.wave = __builtin_amdgcn_readfirstlane(F.tid >> 6); F.G = gridDim.x; F.bid = blockIdx.x;
    const int lo = args.ph_lo, hi = args.ph_hi;
#define REFRESH() do { F.tid = fresh_tid(); F.lane = F.tid & 63; F.wave = __builtin_amdgcn_readfirstlane(F.tid >> 6); } while (0)
#ifndef MK_PHMASK
#define MK_PHMASK 0x3ff
#endif
#define IN(k) (((MK_PHMASK >> (k)) & 1) && lo <= (k) && (k) < hi)
#if MK_MULTI
#define SEAM(k) do { } while (0)
#else
    { volatile LAS unsigned* mw = (volatile LAS unsigned*)(F.lds + MISC_OFF + 1024); if (F.tid < 16) mw[F.tid] = 0u; __syncthreads(); }
    const XcdBarrier xbar = xcd_barrier_post((unsigned*)(F.ws + WS_CTL) + CW_BAR, (volatile LAS unsigned*)(F.lds + MISC_OFF + 1024));
#define SEAM(k) do { if (IN(k) && IN((k) + 1)) { xcd_barrier(xbar); } } while (0)
#endif
    if (IN(0)) { REFRESH(); p0_prologue(F, args); REFRESH(); p1_tables(F, args, 0); } SEAM(0);
    if (IN(1)) { REFRESH();
        { SchedIn8 S{F.G, F.bid, (const char*)F.ws}; EpiInProj E{F.ws}; pg8::gemm_phase<true, false, true>(F.lds, F.ws, 1024, S, E); }
    } SEAM(1);
    if (IN(2)) { REFRESH(); attn_phase(F); retention_phase(F, args); REFRESH(); filler_convert(F, args, 0, 1 << 30); } SEAM(2);
    if (IN(3)) { REFRESH();
        { SchedDense S{F.G, F.bid, (const char*)F.ws, (unsigned)WS_OA, (unsigned)WS_WMT, 256u * 1024u}; EpiMixA E{F.ws}; pg8::gemm_phase<true, true, false>(F.lds, F.ws, 512, S, E); }
        VM_WAIT(); __syncthreads();
        { SchedDense S{F.G, F.bid, (const char*)F.ws, (unsigned)WS_YR, (unsigned)WS_WRT2, 256u * 2048u}; EpiMixB E{F.ws}; pg8::gemm_phase<true, true, false>(F.lds, F.ws, 1024, S, E); }
    } SEAM(3);
    if (IN(4)) { REFRESH();
        SchedDense S{F.G, F.bid, (const char*)F.ws, (unsigned)WS_MIX, (unsigned)WS_WOT, 256u * 2048u}; EpiOut E{args.in[I_X], F.ws, false};
        pg8::gemm_phase<true, false, true>(F.lds, F.ws, 1024, S, E);
    } SEAM(4);
    if (IN(5)) { REFRESH(); router_phase(F, args); } SEAM(5);
    if (IN(7)) { REFRESH();
        build_tables(F);
        SchedExpert<true> S{F.G, F.bid, 4, (const char*)F.ws, (unsigned)WS_X1B8, (unsigned)WS_W1T, 256u * 2048u, 256u * 2048u, 4, (const LAS int*)(F.lds + MISC_OFF), (const LAS int*)(F.lds + TOKT_OFF)};
        fill_unit_tokens(F, S);
        EpiExp1 E{F.ws, (const LAS int*)(F.lds + TOKT_OFF)};
        pg8::gemm_phase<true, false, false>(F.lds, F.ws, 1024, S, E);
        REFRESH(); filler_convert(F, args, 1, 1 << 30);
    } SEAM(7);
    if (IN(8)) { REFRESH();
        build_tables(F);
        SchedExpert<false> S{F.G, F.bid, 8, (const char*)F.ws, (unsigned)WS_ACT, (unsigned)WS_W2T, 256u * 512u, 256u * 512u, 8, (const LAS int*)(F.lds + MISC_OFF), nullptr};
        EpiExp2 E{F.ws, (const LAS int*)(F.lds + MISC_OFF)};
        pg8::gemm_phase<true, true, false>(F.lds, F.ws, 256, S, E);
    } SEAM(8);
    if (IN(9)) { REFRESH(); final_phase(F, args); }
#undef IN
#undef SEAM
}

extern "C" void kernel_launch(void* const* d_in, const int* in_sizes, int n_in, void* d_out, int out_size, void* d_ws, size_t ws_size, hipStream_t stream) {
    static int grid = 0;
    if (grid == 0) {
        if (n_in != 16 || out_size != T * DM || ws_size < WS_END) { fprintf(stderr, "kernel_launch: unexpected shapes (n_in %d out %d ws %zu)\n", n_in, out_size, ws_size); grid = -1; return; }
        int dev = 0, cus = 0, per_cu = 0;
        (void)hipGetDevice(&dev); (void)hipDeviceGetAttribute(&cus, hipDeviceAttributeMultiprocessorCount, dev);
        (void)hipFuncSetAttribute((const void*)mk_fwd, hipFuncAttributeMaxDynamicSharedMemorySize, LDS_BYTES);
        (void)hipOccupancyMaxActiveBlocksPerMultiprocessor(&per_cu, (const void*)mk_fwd, 512, LDS_BYTES);
        if (per_cu < 1) fprintf(stderr, "kernel_launch: occupancy query says %d blocks/CU\n", per_cu);
        (void)hipGetLastError();
        grid = cus > 0 ? cus : 256;
    }
    if (grid < 0) return;
    (void)hipMemsetAsync((char*)d_ws + WS_CTL, 0, CTL_ZERO_BYTES, stream);
    Args a{};
    for (int i = 0; i < 16; ++i) a.in[i] = (const float*)d_in[i];
    a.out = (float*)d_out; a.ws = (unsigned char*)d_ws;
#if MK_MULTI
    for (int p = 0; p < NPHASE; ++p) { a.ph_lo = p; a.ph_hi = p + 1; hipLaunchKernelGGL(mk_fwd, dim3(grid), dim3(512), LDS_BYTES, stream, a); }
#else
    a.ph_lo = 0; a.ph_hi = NPHASE;
    hipLaunchKernelGGL(mk_fwd, dim3(grid), dim3(512), LDS_BYTES, stream, a);
#endif
}
```

```cpp
#include <hip/hip_runtime.h>
#include <hip/hip_cooperative_groups.h>
#include <cstdio>
#include <cstdint>
namespace cg = cooperative_groups;

#ifndef MK_MULTI
#define MK_MULTI 0
#endif

#define GAS __attribute__((address_space(1)))
#define LAS __attribute__((address_space(3)))
typedef unsigned short bf16;
typedef unsigned u32x4 __attribute__((ext_vector_type(4)));
typedef unsigned u32x2 __attribute__((ext_vector_type(2)));
typedef float f32x4 __attribute__((ext_vector_type(4)));
typedef short bf16x8 __attribute__((ext_vector_type(8)));
typedef float f32x16 __attribute__((ext_vector_type(16)));

constexpr int T = 8192, DM = 2048, SEQ = 4096, NBATCH = 2, NIN = 13312, NHEAD = 8;
constexpr int NEXP = 32, DEXP = 512;
constexpr float RMS_EPS = 1e-6f, GN_EPS = 1e-6f;
constexpr int XG_ROWS = 24576;

constexpr size_t MiB = 1u << 20;
constexpr size_t WS_CTL = 0, CTL_ZERO_BYTES = 1 * MiB;
constexpr size_t OFF_KMEAN = 64 * 1024;
constexpr size_t WS_KMEAN1 = 5 * MiB + 512 * 1024;
constexpr size_t OFF_SSQ = 192 * 1024;
constexpr size_t OFF_CNT = 224 * 1024;
constexpr size_t WS_COS = 1 * MiB, WS_SIN = 2 * MiB;
constexpr size_t WS_WRT = 3 * MiB;
constexpr size_t WS_RSTD = 3 * MiB + 256 * 1024;
constexpr size_t WS_LISTTOK = 3 * MiB + 512 * 1024;
constexpr size_t WS_LISTW = 4 * MiB + 512 * 1024;
constexpr size_t WS_HS = 5 * MiB + 768 * 1024;
constexpr size_t WS_DLT = 6 * MiB, WS_DLW = 7 * MiB;
constexpr size_t WS_ROWTOK = 5 * MiB + 512 * 1024;
constexpr size_t WS_ROWW = WS_ROWTOK + 96 * 1024;
constexpr size_t WS_ROWRS = WS_ROWW + 96 * 1024;
constexpr size_t WS_W1T = 8 * MiB;
constexpr size_t WS_W2T = 136 * MiB;
constexpr size_t WS_WMT = 200 * MiB, WS_WRT2 = 204 * MiB, WS_WOT = 212 * MiB;
constexpr size_t WS_WIN8 = 244 * MiB;
constexpr size_t WS_HB8 = 512 * MiB;
constexpr size_t WS_MQ = 304 * MiB, WS_MK = 320 * MiB, WS_MV = 336 * MiB, WS_RQ = 352 * MiB, WS_RK = 368 * MiB;
constexpr size_t WS_RVT = 384 * MiB;
constexpr size_t WS_RG = 416 * MiB, WS_GA = 448 * MiB, WS_GR = 480 * MiB;
constexpr size_t WS_OA = 220 * MiB;
constexpr size_t WS_YR = 236 * MiB;
constexpr size_t WS_MIXA = 272 * MiB;
constexpr size_t WS_MIX = 304 * MiB;
constexpr size_t WS_X1 = 336 * MiB;
constexpr size_t WS_X1B = 400 * MiB;
constexpr size_t WS_XG = 220 * MiB;
constexpr size_t WS_ACT = 432 * MiB;
constexpr size_t WS_X1B8 = 512 * MiB;
constexpr size_t WS_Y = 220 * MiB;
constexpr size_t WS_SSQP = 448 * MiB;
constexpr size_t WS_END = 528 * MiB;

constexpr int RING_BYTES = 131072;
constexpr int MISC_OFF = RING_BYTES;
constexpr int LDS_BYTES = 147456;

__device__ __forceinline__ float bf_lo(unsigned u) { return __uint_as_float(u << 16); }
__device__ __forceinline__ float bf_hi(unsigned u) { return __uint_as_float(u & 0xffff0000u); }
__device__ __forceinline__ float bf2f(bf16 b) { return __uint_as_float(((unsigned)b) << 16); }
__device__ __forceinline__ unsigned f2bf(float f) { unsigned u = __float_as_uint(f); return (u + 0x7fffu + ((u >> 16) & 1u)) >> 16; }
typedef float f32x2_t __attribute__((ext_vector_type(2))); typedef __bf16 bf16x2_t __attribute__((ext_vector_type(2)));
__device__ __forceinline__ unsigned pk2(float lo, float hi) { f32x2_t v = {lo, hi}; bf16x2_t b = __builtin_convertvector(v, bf16x2_t); return __builtin_bit_cast(unsigned, b); }
__device__ __forceinline__ unsigned pk4_fp8(float a, float b, float c, float d) { int w = 0; w = __builtin_amdgcn_cvt_pk_fp8_f32(a, b, w, false); w = __builtin_amdgcn_cvt_pk_fp8_f32(c, d, w, true); return (unsigned)w; }
__device__ __forceinline__ f32x4 unpk4_fp8(unsigned w) { typedef float f2_ __attribute__((ext_vector_type(2))); const f2_ lo = __builtin_amdgcn_cvt_pk_f32_fp8((int)w, false), hi = __builtin_amdgcn_cvt_pk_f32_fp8((int)w, true); return (f32x4){lo.x, lo.y, hi.x, hi.y}; }
__device__ __forceinline__ unsigned pk4_i8(float a, float b, float c, float d) {
    const int ia = (int)__builtin_rintf(a), ib = (int)__builtin_rintf(b), ic = (int)__builtin_rintf(c), id = (int)__builtin_rintf(d);
    return ((unsigned)ia & 255u) | (((unsigned)ib & 255u) << 8) | (((unsigned)ic & 255u) << 16) | ((unsigned)id << 24);
}
__device__ __forceinline__ f32x4 i2f4(f32x4 v) { typedef int i4_ __attribute__((ext_vector_type(4))); const i4_ i = __builtin_bit_cast(i4_, v); return (f32x4){(float)i.x, (float)i.y, (float)i.z, (float)i.w}; }
__device__ __forceinline__ u32x4 pack8(f32x4 a, f32x4 b) { u32x4 w; w.x = pk2(a.x, a.y); w.y = pk2(a.z, a.w); w.z = pk2(b.x, b.y); w.w = pk2(b.z, b.w); return w; }
__device__ __forceinline__ float wave_sum(float v) {
#pragma unroll
    for (int o = 1; o < 64; o <<= 1) v += __shfl_xor(v, o);
    return v;
}
__device__ __forceinline__ float wave_max(float v) {
#pragma unroll
    for (int o = 1; o < 64; o <<= 1) v = fmaxf(v, __shfl_xor(v, o));
    return v;
}
__device__ __forceinline__ float sigmoidf_(float v) { return __builtin_amdgcn_rcpf(1.0f + __builtin_amdgcn_exp2f(v * -1.4426950408889634f)); }
__device__ __forceinline__ float siluf_(float v) { return v * __builtin_amdgcn_rcpf(1.0f + __builtin_amdgcn_exp2f(v * -1.4426950408889634f)); }
__device__ __forceinline__ int fresh_tid() { int t = threadIdx.x; asm volatile("" : "+v"(t)); return t; }
#define LDS_WAIT() asm volatile("s_waitcnt lgkmcnt(0)" ::: "memory")
#define VM_WAIT() asm volatile("s_waitcnt vmcnt(0)" ::: "memory")

__device__ __forceinline__ void st16_wt(unsigned char* ws, const void* p, u32x4 v) {
    const __amdgpu_buffer_rsrc_t r = __builtin_amdgcn_make_buffer_rsrc(ws, 0, 0x7ffff000, 0x00020000);
    __builtin_amdgcn_raw_buffer_store_b128(v, r, (int)(unsigned)((const unsigned char*)p - ws), 0, 16);
}
namespace pg8 {
#define PG8_LAS __attribute__((address_space(3)))
typedef unsigned short bf16_t;
constexpr int BM = 256, BK = 64, HALF = 128, HTB = HALF * BK * 2, STAGE_BYTES = 8 * HTB, NXCD = 8, WGM = 8;

__host__ __device__ __forceinline__ int lds_byte(int r, int c) { const int st = (r >> 4) * 2 + (c >> 5), rr = r & 15, cc = c & 31, ob = rr * 64 + cc * 2; return st * 1024 + (ob ^ (((ob >> 9) & 1) << 5)); }
__host__ __device__ __forceinline__ void stage_rc(int b, int& R, int& C) { const int st = b / 1024, sb = b % 1024, swz = sb ^ (((sb >> 9) & 1) << 5); R = (st >> 1) * 16 + swz / 64; C = (st & 1) * 32 + (swz % 64) / 2; }
__host__ __device__ __forceinline__ int perm32(int rho) { const int n = rho >> 4, i = rho & 15; return 8 * (i >> 2) + 4 * n + (i & 3); }

struct Unit { int pm, pn, kind, aux, slot, lite; };

__device__ __forceinline__ void tile_of(int L, int nM, int nN, int& pm, int& pn) {
    const int nwg = nM * nN;
    int wgid = L; { const int q = nwg / NXCD, r = nwg % NXCD, xcd = wgid % NXCD, off = wgid / NXCD; wgid = (xcd < r ? xcd * (q + 1) : r * (q + 1) + (xcd - r) * q) + off; }
    const int nig = WGM * nN, gid = wgid / nig, fm = gid * WGM, gsz = (nM - fm) < WGM ? (nM - fm) : WGM;
    pm = fm + ((wgid % nig) % gsz); pn = (wgid % nig) / gsz;
}

template <bool FP8, bool CP, bool I8, class Epi, class Sched>
__device__ __forceinline__ void gemm_phase(PG8_LAS unsigned char* lds, unsigned char* wsbase, const int K, const Sched& S, const Epi& E) {
    const __amdgpu_buffer_rsrc_t rsrc = __builtin_amdgcn_make_buffer_rsrc(wsbase, 0, 0x7ffff000, 0x00020000);
    const int tid = fresh_tid(), wid = __builtin_amdgcn_readfirstlane(tid >> 6), lane = tid & 63, wr = wid >> 2, wc = wid & 3, fr = lane & 15, fq = lane >> 4;
    const int nt = K / BK;
    unsigned voffA[2], voffB[2];
    int gR[2]; unsigned gC[2];
#pragma unroll
    for (int i = 0; i < 2; ++i) { int R, C; stage_rc(tid * 16 + i * 8192, R, C); const int Rb = ((R & ~31) + perm32(R & 31));
        const int l5 = perm32(R & 31), Rc = CP ? 64 * (R >> 5) + 16 * (l5 >> 3) + (l5 & 7) : Rb;
        voffA[i] = (unsigned)(R * K + C) * 2u; voffB[i] = (unsigned)(Rc * K + C) * 2u; gR[i] = R; gC[i] = (unsigned)C * 2u; }
    const unsigned kstep = (unsigned)(BK * 2);
    const unsigned hstep = (unsigned)(HALF * K * 2);
    const unsigned hstepB = CP ? (unsigned)(8 * K * 2) : hstep;
    unsigned ldsw = (unsigned)wid * 1024u;
    const int aoff = lds_byte(wr * 64 + fr, fq * 8), boff = lds_byte(wc * 32 + fr, fq * 8);
#define PG8_SA(b, h) (((b) * 2 + (h)) * HTB)
#define PG8_SB(b, h) ((4 + (b) * 2 + (h)) * HTB)
#define PG8_STAGE(bufoff, gbase, voff) do { _Pragma("unroll") for (int _i = 0; _i < 2; ++_i) \
        __builtin_amdgcn_raw_ptr_buffer_load_lds(rsrc, (PG8_LAS unsigned*)(lds + (bufoff) + ldsw + _i * 8192), 16, (int)(voff)[_i], (int)(gbase), 0, 0); } while (0)
#define PG8_STAGE_A(bufoff, gbase, half, isnext) do { if constexpr (Sched::GATHER) { unsigned vo_[2]; const int sl_ = (isnext) ? nslot : cur.slot; \
            _Pragma("unroll") for (int i_ = 0; i_ < 2; ++i_) vo_[i_] = (unsigned)S.arow(sl_, gR[i_] + 128 * (half)) * (unsigned)(2 * K) + gC[i_]; PG8_STAGE(bufoff, gbase, vo_); } \
        else PG8_STAGE(bufoff, (gbase) + (half) * hstep, voffA); } while (0)
#define PG8_LDA(dst, b, h) do { if constexpr (FP8) { _Pragma("unroll") for (int m = 0; m < 4; ++m) dst##8[m] = __builtin_shufflevector(*(const PG8_LAS i32x4_*)(lds + PG8_SA(b, h) + aoff + m * 2048), *(const PG8_LAS i32x4_*)(lds + PG8_SA(b, h) + aoff + m * 2048 + 1024), 0, 1, 2, 3, 4, 5, 6, 7); } \
        else { _Pragma("unroll") for (int m = 0; m < 4; ++m) _Pragma("unroll") for (int k = 0; k < 2; ++k) dst[m][k] = *(const PG8_LAS bf16x8*)(lds + PG8_SA(b, h) + aoff + m * 2048 + k * 1024); } } while (0)
#define PG8_LDB(dst, b, h) do { if constexpr (FP8) { _Pragma("unroll") for (int n = 0; n < 2; ++n) dst##8[n] = __builtin_shufflevector(*(const PG8_LAS i32x4_*)(lds + PG8_SB(b, h) + boff + n * 2048), *(const PG8_LAS i32x4_*)(lds + PG8_SB(b, h) + boff + n * 2048 + 1024), 0, 1, 2, 3, 4, 5, 6, 7); } \
        else { _Pragma("unroll") for (int n = 0; n < 2; ++n) _Pragma("unroll") for (int k = 0; k < 2; ++k) dst[n][k] = *(const PG8_LAS bf16x8*)(lds + PG8_SB(b, h) + boff + n * 2048 + k * 1024); } } while (0)
#define PG8_MMA(ai, bj, At, Bt) do { __builtin_amdgcn_s_setprio(1); _Pragma("unroll") for (int m = 0; m < 4; ++m) _Pragma("unroll") for (int n = 0; n < 2; ++n) { \
        if constexpr (FP8)   \
            { if constexpr (I8) {   \
                i32x4_ c_ = __builtin_bit_cast(i32x4_, acc[ai][bj][m][n]); \
                c_ = __builtin_amdgcn_mfma_i32_16x16x64_i8(__builtin_shufflevector(Bt##8[n], Bt##8[n], 0, 1, 2, 3), __builtin_shufflevector(At##8[m], At##8[m], 0, 1, 2, 3), c_, 0, 0, 0); \
                c_ = __builtin_amdgcn_mfma_i32_16x16x64_i8(__builtin_shufflevector(Bt##8[n], Bt##8[n], 4, 5, 6, 7), __builtin_shufflevector(At##8[m], At##8[m], 4, 5, 6, 7), c_, 0, 0, 0); \
                acc[ai][bj][m][n] = __builtin_bit_cast(f32x4, c_); } \
              else acc[ai][bj][m][n] = __builtin_amdgcn_mfma_scale_f32_16x16x128_f8f6f4(Bt##8[n], At##8[m], acc[ai][bj][m][n], 0, 0, 0, 0x7F7F7F7F, 0, 0x7F7F7F7F); } \
        else { _Pragma("unroll") for (int k = 0; k < 2; ++k) acc[ai][bj][m][n] = __builtin_amdgcn_mfma_f32_16x16x32_bf16(Bt[n][k], At[m][k], acc[ai][bj][m][n], 0, 0, 0); } } \
        __builtin_amdgcn_s_setprio(0); } while (0)
#define PG8_WAIT_V(n) asm volatile("s_waitcnt vmcnt(" #n ")" ::: "memory")
#define PG8_WAIT_L(n) asm volatile("s_waitcnt lgkmcnt(" #n ")" ::: "memory")
#define PG8_BAR __builtin_amdgcn_s_barrier()
#define PG8_SCHED __builtin_amdgcn_sched_barrier(0)
    Unit cur, nxt; int ui = 0;
    if (!S.next(0, cur)) return;
    f32x4 acc[2][2][4][2];
#pragma unroll
    for (int a = 0; a < 2; ++a)
#pragma unroll
        for (int b = 0; b < 2; ++b)
#pragma unroll
            for (int m = 0; m < 4; ++m)
#pragma unroll
                for (int n = 0; n < 2; ++n) acc[a][b][m][n] = (f32x4){0.f, 0.f, 0.f, 0.f};
    typedef int i32x4_ __attribute__((ext_vector_type(4))); typedef int i32x8_ __attribute__((ext_vector_type(8)));
    bf16x8 At[4][2], B0[2][2], B1[2][2]; i32x8_ At8[4], B08[2], B18[2];
    unsigned cA, cB; S.ptrs(cur, cA, cB);
    int nslot = cur.slot;
    bool lite = false; if constexpr (Sched::LITE) lite = cur.lite != 0;
    PG8_STAGE(PG8_SB(0, 0), cB, voffB); PG8_STAGE(PG8_SB(0, 1), cB + hstepB, voffB); PG8_STAGE_A(PG8_SA(0, 0), cA, 0, false); PG8_STAGE_A(PG8_SA(0, 1), cA, 1, false);
    if (wr == 1) PG8_BAR;
    PG8_WAIT_V(2); PG8_BAR;
    PG8_STAGE(PG8_SB(1, 0), cB + kstep, voffB); PG8_STAGE_A(PG8_SA(1, 0), cA + kstep, 0, false); PG8_STAGE(PG8_SB(1, 1), cB + hstepB + kstep, voffB);
    PG8_WAIT_V(6); PG8_BAR;
    for (;;) {
        const bool has_next = S.next(ui + 1, nxt);
        unsigned nA = cA, nB = cB; if (has_next) S.ptrs(nxt, nA, nB);
        nslot = has_next ? nxt.slot : cur.slot;
#define PG8_ON(...) __VA_ARGS__
#define PG8_OFF(...)
#define PG8_KLOOP(H1) _Pragma("unroll 1") \
        for (int t = 0; t < nt; t += 2) { \
            asm volatile("" : "+s"(ldsw));                                     \
            const bool last = (t == nt - 2); \
            const unsigned a1 = cA + (unsigned)(t + 1) * kstep; \
            const unsigned a2 = last ? nA : cA + (unsigned)(t + 2) * kstep, b2 = last ? nB : cB + (unsigned)(t + 2) * kstep; \
            const unsigned a3 = a2 + kstep, b3 = b2 + kstep; \
            PG8_LDB(B0, 0, 0); PG8_LDB(B1, 0, 1); PG8_SCHED; PG8_LDA(At, 0, 0); PG8_STAGE_A(PG8_SA(1, 1), a1, 1, false); \
            PG8_WAIT_V(8); PG8_WAIT_L(0); PG8_BAR; PG8_MMA(0, 0, At, B0); PG8_MMA(0, 1, At, B1); PG8_BAR; PG8_SCHED; \
            H1(PG8_LDA(At, 0, 1);) PG8_STAGE(PG8_SB(0, 0), b2, voffB); PG8_STAGE(PG8_SB(0, 1), b2 + hstepB, voffB); PG8_STAGE_A(PG8_SA(0, 0), a2, 0, last); \
            PG8_WAIT_V(8); PG8_WAIT_L(0); PG8_BAR; H1(PG8_MMA(1, 0, At, B0); PG8_MMA(1, 1, At, B1);) PG8_BAR; PG8_SCHED; \
            PG8_LDB(B0, 1, 0); PG8_LDB(B1, 1, 1); PG8_SCHED; PG8_LDA(At, 1, 0); PG8_STAGE_A(PG8_SA(0, 1), a2, 1, last); \
            PG8_WAIT_V(8); PG8_WAIT_L(0); PG8_BAR; PG8_MMA(0, 0, At, B0); PG8_MMA(0, 1, At, B1); PG8_BAR; PG8_SCHED; \
            H1(PG8_LDA(At, 1, 1);) PG8_STAGE(PG8_SB(1, 0), b3, voffB); PG8_STAGE(PG8_SB(1, 1), b3 + hstepB, voffB); PG8_STAGE_A(PG8_SA(1, 0), a3, 0, last); \
            PG8_WAIT_V(8); PG8_WAIT_L(0); PG8_BAR; H1(PG8_MMA(1, 0, At, B0); PG8_MMA(1, 1, At, B1);) PG8_BAR; PG8_SCHED; \
        }
        if (Sched::LITE && lite) { PG8_KLOOP(PG8_OFF) } else { PG8_KLOOP(PG8_ON) }
#undef PG8_KLOOP
#undef PG8_ON
#undef PG8_OFF
        if (wr == 0) PG8_BAR;
        if constexpr (I8) {
#pragma unroll
            for (int a = 0; a < 2; ++a)
#pragma unroll
                for (int b = 0; b < 2; ++b)
#pragma unroll
                    for (int m = 0; m < 4; ++m)
#pragma unroll
                        for (int n = 0; n < 2; ++n) acc[a][b][m][n] = i2f4(acc[a][b][m][n]);
        }
        E(acc, cur, wr, wc, fr, fq);
        if (!has_next) break;
#pragma unroll
        for (int a = 0; a < 2; ++a)
#pragma unroll
            for (int b = 0; b < 2; ++b)
#pragma unroll
                for (int m = 0; m < 4; ++m)
#pragma unroll
                    for (int n = 0; n < 2; ++n) acc[a][b][m][n] = (f32x4){0.f, 0.f, 0.f, 0.f};
        cur = nxt; cA = nA; cB = nB; ++ui;
        if constexpr (Sched::LITE) lite = cur.lite != 0;
        if (wr == 1) PG8_BAR;
    }
    PG8_WAIT_V(0);
    PG8_BAR;
#undef PG8_SA
#undef PG8_SB
#undef PG8_STAGE
#undef PG8_STAGE_A
#undef PG8_LDA
#undef PG8_LDB
#undef PG8_MMA
#undef PG8_WAIT_V
#undef PG8_WAIT_L
#undef PG8_BAR
#undef PG8_SCHED
}
}
using pg8::Unit;
typedef const f32x4 (&AccRef)[2][2][4][2];

struct Args { const float* in[16]; float* out; unsigned char* ws; int ph_lo, ph_hi; };

struct Frame {
    LAS unsigned char* lds; unsigned char* ldsg;
    unsigned char* ws;
    int tid, lane, wave, G, bid;
};
template <class Tp> __device__ __forceinline__ Tp* wsp(const Frame& F, size_t off) { return (Tp*)(F.ws + off); }
enum { I_X = 0, I_NORM_MIX = 1, I_W_IN = 2, I_GN_W = 3, I_W_BM = 4, I_W_BR = 5, I_W_OUT = 6, I_NORM_FFN = 7, I_W_RG = 8, I_B_RG = 9, I_W_RE = 10, I_B_RE = 11, I_W_EG = 12, I_W_EU = 13, I_W_ED = 14, I_NORM_FINAL = 15 };


constexpr int CW_BAR = 4096;
#define XB_TMO      128
#define XB_XCNT(j)  (256  + 64 * (j))
#define XB_XSUB(j)  (1280 + 64 * (j))
#define XB_XGEN(j)  (2304 + 64 * (j))
#define XB_TOP      3328
#define XB_TOPGEN   3392
#define XCD_BAR_WORDS 3456
#define XB_SPIN_CAP (1u << 22)
__device__ __forceinline__ unsigned xb_ld(unsigned* p)              { return __hip_atomic_load(p, __ATOMIC_RELAXED, __HIP_MEMORY_SCOPE_AGENT); }
__device__ __forceinline__ unsigned xb_add(unsigned* p, unsigned v) { return __hip_atomic_fetch_add(p, v, __ATOMIC_RELAXED, __HIP_MEMORY_SCOPE_AGENT); }
__device__ __forceinline__ unsigned xb_xcc_id() { return (unsigned)__builtin_amdgcn_s_getreg((3 << 11) | 20) & 0xFu; }
#define XB_SPIN(cond, bar) do { unsigned _sp = 0; while (cond) { __builtin_amdgcn_s_sleep(1); \
    if ((++_sp & 255u) == 0u) { if (xb_ld(&(bar)[XB_TMO])) break; if (_sp > XB_SPIN_CAP) { atomicAdd(&(bar)[XB_TMO], 1u); break; } } } } while (0)
struct XcdBarrier { unsigned* bar; unsigned x; volatile LAS unsigned* st; };
__device__ __forceinline__ XcdBarrier xcd_barrier_post(unsigned* bar, volatile LAS unsigned* st) {
    XcdBarrier b; b.bar = bar; b.x = xb_xcc_id(); b.st = st;
    if (threadIdx.x == 0) (void)xb_add(&bar[XB_XCNT(b.x)], 1u);
    return b;
}
__device__ __forceinline__ void xcd_barrier_complete(unsigned* bar, unsigned x, unsigned& nloc, unsigned& nx) {
    const unsigned G = gridDim.x * gridDim.y * gridDim.z;
    unsigned sum, cnt, mine, sp = 0u;
    for (;;) {
        sum = 0u; cnt = 0u; mine = 0u;
#pragma unroll
        for (unsigned j = 0; j < 16; ++j) { const unsigned c = xb_ld(&bar[XB_XCNT(j)]); sum += c; cnt += (c > 0u) ? 1u : 0u; mine = (j == x) ? c : mine; }
        if (sum == G) break;
        __builtin_amdgcn_s_sleep(1);
        if ((++sp & 255u) == 0u) { if (xb_ld(&bar[XB_TMO])) break; if (sp > XB_SPIN_CAP) { atomicAdd(&bar[XB_TMO], 1u); break; } }
    }
    nloc = mine > 0u ? mine : 1u; nx = cnt > 0u ? cnt : 1u;
}
__device__ __forceinline__ void xcd_barrier(const XcdBarrier& b) {
    asm volatile("s_waitcnt vmcnt(0)" ::: "memory");
    __syncthreads();
    if (threadIdx.x == 0) {
        unsigned* bar = b.bar;
        __builtin_amdgcn_s_waitcnt(0);
        unsigned nloc = b.st[0], nx = b.st[1];
        if (nloc == 0u) { xcd_barrier_complete(bar, b.x, nloc, nx); b.st[0] = nloc; b.st[1] = nx; }
        const unsigned old = xb_add(&bar[XB_XSUB(b.x)], 1u);
        const unsigned gen = old / nloc;
        if (old + 1u == (gen + 1u) * nloc) {
            __builtin_amdgcn_fence(__ATOMIC_RELEASE, "agent");
            asm volatile("s_waitcnt vmcnt(0)" ::: "memory");
            const unsigned og = xb_add(&bar[XB_TOP], 1u);
            const unsigned tg = og / nx;
            if (og + 1u == (tg + 1u) * nx) xb_add(&bar[XB_TOPGEN], 1u);
            else XB_SPIN(xb_ld(&bar[XB_TOPGEN]) == tg, bar);
            __builtin_amdgcn_fence(__ATOMIC_ACQUIRE, "agent");
            xb_add(&bar[XB_XGEN(b.x)], 1u);
            asm volatile("s_waitcnt vmcnt(0)" ::: "memory");
        } else {
            XB_SPIN(xb_ld(&bar[XB_XGEN(b.x)]) == gen, bar);
            __builtin_amdgcn_fence(__ATOMIC_ACQUIRE, "agent");
            asm volatile("s_waitcnt vmcnt(0)" ::: "memory");
        }
    }
    __syncthreads();
}

constexpr float W_IN_SCALE = 1024.0f;
struct TItem { const float* src; const float* ksc; bf16* dst; int N, K; float fp8; };
__device__ __forceinline__ int win_drow(int n0, int& fp8) {
    fp8 = 1;
    if (n0 < 3072) return n0;
    if (n0 < 5120) { const int t0 = (n0 - 3072) & ~255, c = n0 & 255, hl = c >> 7, d = c & 127, half = d >> 6, i = d & 63; return 9216 + t0 + half * 128 + hl * 64 + i; }
    if (n0 < 7168) return n0 - 5120 + 11264;
    return n0 - 7168 + 3072;
}
constexpr int TI_IN8 = 16 * 416, TI_IN = TI_IN8, TI_WM = 8 * 64, TI_WR = 16 * 64, TI_WO = 16 * 64, TI_E = 32 * 256;
constexpr int TI_DENSE = TI_IN + TI_WM + TI_WR + TI_WO, TI_ALL = TI_DENSE + 3 * TI_E;
__device__ __forceinline__ TItem titem_decode(const Frame& F, const Args& A, int it, int lane) {
    const float* W; const float* ksc = nullptr; bf16* WT; int K, N, k0, n0, drow0, fp8 = 0; unsigned char* W8 = F.ws + WS_WIN8; float s8 = 64.f;
    int r = it;
    if (r < TI_IN) { const int kb = r / 416, nb = r % 416; W = A.in[I_W_IN]; K = 2048; N = NIN; WT = nullptr; n0 = nb * 32; drow0 = win_drow(n0, fp8); k0 = kb * 128; s8 = -W_IN_SCALE; }
    else if ((r -= TI_IN) < TI_WM) { const int kb = r / 64, nb = r % 64; W = A.in[I_W_BM]; K = 1024; N = 2048; WT = nullptr; fp8 = 1; W8 = F.ws + WS_WMT; s8 = 32.f; k0 = kb * 128; n0 = nb * 32; drow0 = n0; }
    else if ((r -= TI_WM) < TI_WR) { const int kb = r / 64, nb = r % 64; W = A.in[I_W_BR]; K = 2048; N = 2048; WT = nullptr; fp8 = 1; W8 = F.ws + WS_WRT2; s8 = 32.f; k0 = kb * 128; n0 = nb * 32; drow0 = n0; }
    else if ((r -= TI_WR) < TI_WO) { const int kb = r / 64, nb = r % 64; W = A.in[I_W_OUT]; K = 2048; N = 2048; WT = nullptr; fp8 = 1; W8 = F.ws + WS_WOT; s8 = -W_IN_SCALE; k0 = kb * 128; n0 = nb * 32; drow0 = n0; }
    else if ((r -= TI_WO) < 2 * TI_E) { const int up = r >= TI_E; if (up) r -= TI_E; const int e = r >> 8, q = r & 255, kb = q >> 4, nb = q & 15;
        W = (up ? A.in[I_W_EU] : A.in[I_W_EG]) + (size_t)e * 2048 * 512; ksc = A.in[I_NORM_FFN]; K = 2048; N = 512; WT = nullptr; fp8 = 1; W8 = F.ws + WS_W1T; s8 = 64.f; k0 = kb * 128; n0 = nb * 32; drow0 = e * 1024 + (n0 >> 7) * 256 + up * 128 + (n0 & 127); }
    else { r -= 2 * TI_E; const int e = r >> 8, q = r & 255, kb = q >> 6, nb = q & 63; W = A.in[I_W_ED] + (size_t)e * 512 * 2048; K = 512; N = 2048; WT = nullptr; fp8 = 1; W8 = F.ws + WS_W2T; s8 = 32.f; k0 = kb * 128; n0 = nb * 32; drow0 = e * 2048 + n0; }
    const int c = lane & 7, g = (lane >> 3) * (fp8 ? 16 : 8);
    TItem t; t.src = W + (size_t)(k0 + g) * N + n0 + 4 * c; t.ksc = ksc ? ksc + k0 + g : nullptr; t.N = N; t.K = K; t.fp8 = fp8 ? s8 : 0.f;
    if (fp8) t.dst = (bf16*)(W8 + (size_t)(drow0 + 4 * c) * K + k0 + g); else t.dst = WT + (size_t)(drow0 + 4 * c) * K + k0 + g;
    return t;
}
__device__ __forceinline__ void titem_load(const TItem& t, f32x4 (&v)[16]) {
#pragma unroll
    for (int i = 0; i < 8; ++i) v[i] = __builtin_nontemporal_load((const GAS f32x4*)(t.src + (size_t)i * t.N));
    if (t.fp8 != 0.f) {
#pragma unroll
        for (int i = 8; i < 16; ++i) v[i] = __builtin_nontemporal_load((const GAS f32x4*)(t.src + (size_t)i * t.N)); }
}
__device__ __forceinline__ void titem_store(const TItem& t, f32x4 (&v)[16], unsigned char* ws) {
    if (t.fp8 != 0.f) {
        if (t.ksc) {
#pragma unroll
            for (int q = 0; q < 4; ++q) { const f32x4 sq = *(const GAS f32x4*)(t.ksc + 4 * q); v[4 * q] *= sq.x; v[4 * q + 1] *= sq.y; v[4 * q + 2] *= sq.z; v[4 * q + 3] *= sq.w; } }
        if (t.fp8 < 0.f) { const float s = -t.fp8;
#define I8C(x_) __builtin_amdgcn_fmed3f((x_) * s, -127.0f, 127.0f)
#pragma unroll
            for (int j = 0; j < 4; ++j) { u32x4 o; o.x = pk4_i8(I8C(v[0][j]), I8C(v[1][j]), I8C(v[2][j]), I8C(v[3][j])); o.y = pk4_i8(I8C(v[4][j]), I8C(v[5][j]), I8C(v[6][j]), I8C(v[7][j]));
                o.z = pk4_i8(I8C(v[8][j]), I8C(v[9][j]), I8C(v[10][j]), I8C(v[11][j])); o.w = pk4_i8(I8C(v[12][j]), I8C(v[13][j]), I8C(v[14][j]), I8C(v[15][j]));
                st16_wt(ws, (unsigned char*)t.dst + (size_t)j * t.K, o); }
#undef I8C
            return; }
        const float s = t.fp8;
#pragma unroll
        for (int j = 0; j < 4; ++j) { u32x4 o; o.x = pk4_fp8(v[0][j] * s, v[1][j] * s, v[2][j] * s, v[3][j] * s); o.y = pk4_fp8(v[4][j] * s, v[5][j] * s, v[6][j] * s, v[7][j] * s);
            o.z = pk4_fp8(v[8][j] * s, v[9][j] * s, v[10][j] * s, v[11][j] * s); o.w = pk4_fp8(v[12][j] * s, v[13][j] * s, v[14][j] * s, v[15][j] * s);
            st16_wt(ws, (unsigned char*)t.dst + (size_t)j * t.K, o); }
        return; }
#pragma unroll
    for (int j = 0; j < 4; ++j) { u32x4 o; o.x = pk2(v[0][j], v[1][j]); o.y = pk2(v[2][j], v[3][j]); o.z = pk2(v[4][j], v[5][j]); o.w = pk2(v[6][j], v[7][j]);
        st16_wt(ws, t.dst + (size_t)j * t.K, o); }
}
__device__ __forceinline__ void transpose_items(Frame& F, const Args& A, int first, int last, int start, int NGW) {
    const int lane = F.lane;
    int it = first + start; if (it >= last) return;
    TItem cur = titem_decode(F, A, it, lane); f32x4 v[16]; titem_load(cur, v);
    for (;;) {
        const int nx = it + NGW; const bool more = nx < last;
        TItem nxt = cur; f32x4 w[16];
        if (more) { nxt = titem_decode(F, A, nx, lane); titem_load(nxt, w); }
        titem_store(cur, v, F.ws);
        if (!more) break;
        cur = nxt; it = nx;
#pragma unroll
        for (int i = 0; i < 16; ++i) v[i] = w[i];
    }
}
constexpr size_t OFF_FILL = 228 * 1024;
constexpr int FILL_A_FIRST = TI_IN, FILL_A_CHUNKS = (TI_ALL - TI_E - TI_IN) / 32, FILL_B_FIRST = TI_ALL - TI_E, FILL_B_CHUNKS = TI_E / 32;
static_assert((TI_ALL - TI_E - TI_IN) % 32 == 0 && TI_E % 32 == 0, "filler chunks");
__device__ __forceinline__ void filler_convert(Frame& F, const Args& A, int which, int max_chunks) {
    volatile LAS int* slot = (volatile LAS int*)(F.lds + MISC_OFF + 2048);
    unsigned* ctr = (unsigned*)(F.ws + OFF_FILL) + 64 * which;
    const int first = which ? FILL_B_FIRST : FILL_A_FIRST, nch = which ? FILL_B_CHUNKS : FILL_A_CHUNKS;
    if (max_chunks <= 0) return;
    int nxt = 0; if (F.tid == 0) nxt = (int)atomicAdd(ctr, 1u);
    for (int n_ = 0; n_ < max_chunks; ++n_) {
        __syncthreads();
        if (F.tid == 0) *slot = nxt;
        __syncthreads();
        const int ch = *slot;
        if (ch >= nch) break;
        if (F.tid == 0) nxt = (int)atomicAdd(ctr, 1u);
        transpose_items(F, A, first + ch * 32, first + ch * 32 + 32, F.wave, 8);
    }
}
__device__ __forceinline__ void p0_prologue(Frame& F, const Args& A) {
    const int gw = F.bid * 8 + F.wave, NGW = F.G * 8, lane = F.lane;
    transpose_items(F, A, 0, TI_IN, gw, NGW);
    f32x4 w[8];
    { const GAS f32x4* wr = (const GAS f32x4*)A.in[I_NORM_MIX] + lane;
#pragma unroll
      for (int j = 0; j < 8; ++j) w[j] = wr[64 * j]; }
    int m = gw; if (m >= T) return;
    f32x4 v[8], nx[8];
    { const GAS f32x4* xr = (const GAS f32x4*)(A.in[I_X] + (size_t)m * DM) + lane;
#pragma unroll
      for (int j = 0; j < 8; ++j) v[j] = xr[64 * j]; }
    for (;;) {
        const int mn = m + NGW; const bool more = mn < T;
        if (more) { const GAS f32x4* xr = (const GAS f32x4*)(A.in[I_X] + (size_t)mn * DM) + lane;
#pragma unroll
            for (int j = 0; j < 8; ++j) nx[j] = xr[64 * j]; }
        float s = 0.f;
#pragma unroll
        for (int j = 0; j < 8; ++j) s += (v[j].x * v[j].x + v[j].y * v[j].y) + (v[j].z * v[j].z + v[j].w * v[j].w);
        const float rstd = 1.0f / sqrtf(wave_sum(s) * (1.0f / DM) + RMS_EPS);
        float am = 0.f;
#pragma unroll
        for (int j = 0; j < 8; ++j) { v[j] = v[j] * rstd * w[j]; am = fmaxf(fmaxf(am, fmaxf(fabsf(v[j].x), fabsf(v[j].y))), fmaxf(fabsf(v[j].z), fabsf(v[j].w))); }
        am = fmaxf(wave_max(am), 1e-20f);
        const float qs = 127.0f / am;
        GAS unsigned* o4 = (GAS unsigned*)(F.ws + WS_HB8 + (size_t)m * DM) + lane;
#pragma unroll
        for (int j = 0; j < 8; ++j) o4[64 * j] = pk4_i8(v[j].x * qs, v[j].y * qs, v[j].z * qs, v[j].w * qs);
        if (lane == 0) wsp<float>(F, WS_HS)[m] = am * (1.0f / 127.0f);
        if (!more) break;
        m = mn;
#pragma unroll
        for (int j = 0; j < 8; ++j) v[j] = nx[j];
    }
}
__device__ __forceinline__ void p1_tables(Frame& F, const Args& A, int first) {
    const int t0 = (F.bid - first) * 512 + F.tid, tstride = (F.G - first) * 512;
    { float* COS = wsp<float>(F, WS_COS); float* SIN = wsp<float>(F, WS_SIN);
      for (int idx = t0; idx < SEQ * 64; idx += tstride) { const int s = idx >> 6, i = idx & 63;
          const float inv = (float)pow(10000.0, -(double)i / 64.0); const float ang = (float)s * inv;
          COS[idx] = (float)cos((double)ang); SIN[idx] = (float)sin((double)ang); } }
    { bf16* WRT = wsp<bf16>(F, WS_WRT);
      for (int idx = t0; idx < 64 * 2048; idx += tstride) { const int j = idx >> 11, k = idx & 2047; float v = 0.f;
          if (j < 4) v = A.in[I_W_RG][k * 4 + j]; else if (j < 36) { const int g = (j - 4) >> 3, e = (j - 4) & 7; v = A.in[I_W_RE][((size_t)g * 2048 + k) * 8 + e]; }
          WRT[idx] = (bf16)f2bf(v * A.in[I_NORM_FFN][k]); } }
}

struct SchedIn8 {
    static constexpr bool GATHER = false, LITE = false;
    int G, c; const char* ws;
    __device__ __forceinline__ bool next(int i, Unit& u) const {
        const int L = i * G + c; if (L >= 1664) return false;
        if (L < 1408) { int pm, j; pg8::tile_of(L, 32, 44, pm, j); u.pm = pm; u.pn = j < 12 ? j : (j < 36 ? 16 + j : j - 24); u.kind = 0; u.aux = j; }
        else { const int q = L - 1408; u.pm = q >> 5; u.pn = q & 31; u.kind = 1; u.aux = 44 + u.pm; }
        u.slot = i; return true;
    }
    __device__ __forceinline__ void ptrs(const Unit& u, unsigned& a, unsigned& b) const {
        constexpr unsigned ts = 256u * 2048u, H = (unsigned)WS_HB8, W = (unsigned)WS_WIN8;
        if (u.kind == 0) { a = H + (unsigned)u.pm * ts; b = W + (unsigned)u.aux * ts; } else { a = W + (unsigned)u.aux * ts; b = H + (unsigned)u.pn * ts; }
    }
    __device__ __forceinline__ int arow(int, int) const { return 0; }
};
struct EpiInProj {
    unsigned char* ws;
    __device__ __forceinline__ void operator()(AccRef acc, const Unit& u, int wr, int wc, int fr, int fq) const {
        asm volatile("" : "+v"(fr), "+v"(fq));
        bf16* MQ = (bf16*)(ws + WS_MQ); bf16* RQ = (bf16*)(ws + WS_RQ); bf16* RVT = (bf16*)(ws + WS_RVT); bf16* RG = (bf16*)(ws + WS_RG); float* KMEAN = (float*)(ws + (wr ? WS_KMEAN1 : OFF_KMEAN)); const float* COS = (const float*)(ws + WS_COS); const float* SIN = (const float*)(ws + WS_SIN);
        const float* HS = (const float*)(ws + WS_HS);
        if (u.kind == 1) {
            const int b = u.pn >> 4, s0 = (u.pn & 15) * 256 + wc * 32 + 8 * fq;
            bf16* base = RVT + ((size_t)(b * 8 + u.pm) * 256) * 4096 + s0;
            const float* hs = HS + (size_t)u.pn * 256 + wc * 32 + 8 * fq;
            f32x4 cs[2][2];
#pragma unroll
            for (int bj = 0; bj < 2; ++bj)
#pragma unroll
                for (int n = 0; n < 2; ++n) cs[bj][n] = *(const GAS f32x4*)(hs + bj * 128 + 4 * n) * (1.0f / W_IN_SCALE);
#pragma unroll
            for (int ai = 0; ai < 2; ++ai)
#pragma unroll
                for (int m = 0; m < 4; ++m) { const int dv = ai * 128 + wr * 64 + m * 16 + fr;
#pragma unroll
                    for (int bj = 0; bj < 2; ++bj) *(GAS u32x4*)(base + (size_t)dv * 4096 + bj * 128) = pack8(acc[ai][bj][m][0] * cs[bj][0], acc[ai][bj][m][1] * cs[bj][1]); }
            return;
        }
        const int pn = u.pn, b = u.pm >> 4;
#define sb ((u.pm & 15) * 256 + wr * 64 + fr)
#define c8 (wc * 32 + 8 * fq)
#define RS(ai_, m_) (HS[(size_t)u.pm * 256 + wr * 64 + fr + (ai_) * 128 + (m_) * 16] * (1.0f / W_IN_SCALE))
        if (pn < 12) {
            asm volatile("" : "+v"(fr), "+v"(fq));
            const int which = pn >> 2; bf16* dst = MQ + (size_t)which * (8u << 20);
#pragma unroll
            for (int bj = 0; bj < 2; ++bj) { const int head = (pn & 3) * 2 + bj; bf16* hb = dst + ((size_t)(b * 8 + head) * 4096) * 128 + c8;
#pragma unroll
                for (int ai = 0; ai < 2; ++ai)
#pragma unroll
                    for (int m = 0; m < 4; ++m) *(GAS u32x4*)(hb + (size_t)(sb + ai * 128 + m * 16) * 128) = pack8(acc[ai][bj][m][0] * RS(ai, m), acc[ai][bj][m][1] * RS(ai, m)); }
            if (which == 1) {
#pragma unroll
                for (int bj = 0; bj < 2; ++bj) { const int head = (pn & 3) * 2 + bj;
#pragma unroll
                    for (int n = 0; n < 2; ++n) { f32x4 s = (f32x4){0.f, 0.f, 0.f, 0.f};
#pragma unroll
                        for (int ai = 0; ai < 2; ++ai)
#pragma unroll
                            for (int m = 0; m < 4; ++m) s += acc[ai][bj][m][n] * RS(ai, m);
#pragma unroll
                        for (int j = 0; j < 4; ++j) { float v = s[j]; v += __shfl_xor(v, 1); v += __shfl_xor(v, 2); v += __shfl_xor(v, 4); v += __shfl_xor(v, 8);
                            if (fr == 0) KMEAN[((size_t)((b * 8 + head) * 16 + (u.pm & 15))) * 128 + c8 + 4 * n + j] = v * (1.0f / 256.0f); } } }
            }
        } else if (pn < 20) {
            asm volatile("" : "+v"(fr), "+v"(fq));
            const bool isk = pn >= 16; const int head = ((pn - 12) & 3) * 2 + (wc >> 1), i0 = (wc & 1) * 32 + 8 * fq;
            bf16* hb = RQ + (isk ? (size_t)(8u << 20) : (size_t)0) + ((size_t)(b * 8 + head) * 4096) * 128 + i0;
            const float nlg = -log2f(1.0f - exp2f(-(5.0f + (float)head)));
#pragma unroll
            for (int ai = 0; ai < 2; ++ai)
#pragma unroll
                for (int m = 0; m < 4; ++m) { const int s = sb + ai * 128 + m * 16;
                    const float sc = (isk ? 0.08838834764831845f * exp2f((float)((s & 127) + 1) * nlg) : 1.0f) * RS(ai, m);
                    const GAS f32x4* cp = (const GAS f32x4*)(COS + (size_t)s * 64 + i0); const GAS f32x4* sp = (const GAS f32x4*)(SIN + (size_t)s * 64 + i0);
                    f32x4 o1[2], o2[2];
#pragma unroll
                    for (int n = 0; n < 2; ++n) { const f32x4 c = cp[n], sn = sp[n], x1 = acc[ai][0][m][n], x2 = acc[ai][1][m][n];
                        o1[n] = (x1 * c - x2 * sn) * sc; o2[n] = (x1 * sn + x2 * c) * sc; }
                    *(GAS u32x4*)(hb + (size_t)s * 128) = pack8(o1[0], o1[1]); *(GAS u32x4*)(hb + (size_t)s * 128 + 64) = pack8(o2[0], o2[1]); }
        } else {
            asm volatile("" : "+v"(fr), "+v"(fq));
            const int which = pn < 36 ? 0 : (pn < 44 ? 1 : 2); bf16* dst = RG + (size_t)which * (16u << 20);
            const int col0 = (pn - 28 - 8 * which) * 256 + c8;
#pragma unroll
            for (int ai = 0; ai < 2; ++ai)
#pragma unroll
                for (int m = 0; m < 4; ++m) { bf16* rp = dst + (size_t)(u.pm * 256 + wr * 64 + fr + ai * 128 + m * 16) * 2048 + col0;
#pragma unroll
                    for (int bj = 0; bj < 2; ++bj) { f32x4 v0 = acc[ai][bj][m][0] * RS(ai, m), v1 = acc[ai][bj][m][1] * RS(ai, m);
#pragma unroll
                        for (int j = 0; j < 4; ++j) { const float s0 = sigmoidf_(v0[j]), s1 = sigmoidf_(v1[j]); v0[j] = which == 0 ? v0[j] * s0 : s0; v1[j] = which == 0 ? v1[j] * s1 : s1; }
                        if (which == 1) { u32x2 o8; o8.x = pk4_fp8(v0.x, v0.y, v0.z, v0.w); o8.y = pk4_fp8(v1.x, v1.y, v1.z, v1.w);
                            *(GAS u32x2*)((unsigned char*)(ws + WS_GA) + (size_t)(u.pm * 256 + wr * 64 + fr + ai * 128 + m * 16) * 2048 + col0 + bj * 128) = o8; }
                        else *(GAS u32x4*)(rp + bj * 128) = pack8(v0, v1); } }
        }
#undef RS
#undef sb
#undef c8
    }
};
namespace att {
constexpr int D = 128, OSTR = 1024;
constexpr float THR = 8.f;
constexpr bool WSKIP = false;
constexpr float SCALE = 0.08838834764831845f;
constexpr int NW = 8, QBLK = 32, KVBLK = 64, QB = NW * QBLK;
constexpr int SHM_V = KVBLK * D * 2, SHM_K = KVBLK * D * 2;
constexpr int LDS_BYTES = 2 * SHM_V + 2 * SHM_K + NW * 64 * 4;
typedef short bf16x8 __attribute__((ext_vector_type(8)));
typedef short s16x4 __attribute__((ext_vector_type(4)));
typedef float f32x16 __attribute__((ext_vector_type(16)));
typedef float f32x4 __attribute__((ext_vector_type(4)));
__device__ __forceinline__ unsigned moba_select(const bf16x8* qr, const __attribute__((address_space(3))) float* KM, int qb, int hi) {
    if (qb == 0) return 0u;
    const float NEG = -__builtin_inff();
    float v1 = NEG, v2 = NEG, v3 = NEG; int i1 = 0, i2 = 0, i3 = 0;
    __builtin_amdgcn_sched_barrier(0);
#pragma unroll 1
    for (int j = 0; j < qb; ++j) {
        const __attribute__((address_space(3))) f32x4* km = (const __attribute__((address_space(3))) f32x4*)(KM + j * 128 + hi * 8); float a = 0.f;
#pragma unroll
        for (int d0 = 0; d0 < 8; ++d0) { const f32x4 k0 = km[d0 * 4], k1 = km[d0 * 4 + 1]; const bf16x8 q = qr[d0];
#define QF(e) __uint_as_float(((unsigned)(unsigned short)q[e]) << 16)
            a = fmaf(QF(0), k0.x, a); a = fmaf(QF(1), k0.y, a); a = fmaf(QF(2), k0.z, a); a = fmaf(QF(3), k0.w, a);
            a = fmaf(QF(4), k1.x, a); a = fmaf(QF(5), k1.y, a); a = fmaf(QF(6), k1.z, a); a = fmaf(QF(7), k1.w, a);
#undef QF
        }
        a += __shfl_xor(a, 32);
        const bool g1 = a > v1, g2 = a > v2, g3 = a > v3;
        v3 = g2 ? v2 : (g3 ? a : v3); i3 = g2 ? i2 : (g3 ? j : i3);
        v2 = g1 ? v1 : (g2 ? a : v2); i2 = g1 ? i1 : (g2 ? j : i2);
        v1 = g1 ? a : v1; i1 = g1 ? j : i1;
        asm volatile("" : "+v"(v1), "+v"(v2), "+v"(v3));
    }
    unsigned sel = 0u;
    if (v1 > NEG) sel |= 1u << i1;
    if (v2 > NEG) sel |= 1u << i2;
    if (v3 > NEG) sel |= 1u << i3;
    asm volatile("" : "+v"(sel));
    __builtin_amdgcn_sched_barrier(0);
    return sel;
}
typedef unsigned u32x4 __attribute__((ext_vector_type(4)));
template <class A, class Bt> struct same_t { static constexpr bool v = false; };
template <class A> struct same_t<A, A> { static constexpr bool v = true; };

#define KSWZ(row, colB) ((row) * 256 + ((colB) ^ (((row) & 7) << 4)))
#define SBAR() __builtin_amdgcn_sched_barrier(0)
__device__ __forceinline__ int v_st(int k, int c) { const int kk = (k & ~0xC) | ((k & 4) << 1) | ((k & 8) >> 1); return ((kk >> 3) * 4 + (c >> 5)) * 512 + ((kk & 7) * 32 + (c & 31)) * 2; }
__device__ __forceinline__ int v_rd_base(int lane) { return ((lane & 3) << 3) | (((lane >> 2) & 3) << 6) | (((lane >> 4) & 1) << 5) | (((lane >> 5) & 1) << 8); }
constexpr int v_rd_off(int d0, int ks, int half) { return d0 * 512 + ks * 4096 + half * 2048; }
__device__ __forceinline__ int crow(int r, int hi) { return (r & 3) + 8 * (r >> 2) + 4 * hi; }
__device__ __forceinline__ unsigned cvtpk(float lo, float hi) {
    unsigned r; asm volatile("v_cvt_pk_bf16_f32 %0, %1, %2" : "=v"(r) : "v"(lo), "v"(hi)); return r;
}
__device__ __forceinline__ bf16x8 pack8(f32x4 a, f32x4 b) {
    u32x4 w = {cvtpk(a[0], a[1]), cvtpk(a[2], a[3]), cvtpk(b[0], b[1]), cvtpk(b[2], b[3])};
    return *reinterpret_cast<bf16x8*>(&w);
}
template <class T> __device__ __forceinline__ bf16x8 load8(const T* p) {
    if constexpr (same_t<T, float>::v) { return pack8(*(const f32x4*)p, *(const f32x4*)(p + 4)); }
    else { return *reinterpret_cast<const bf16x8*>(p); }
}
__device__ __forceinline__ void mask_tile(f32x16& p0, f32x16& p1, int dq, unsigned W) {
    const float NEG = -__builtin_inff();
#pragma unroll
    for (int r = 0; r < 16; ++r) {
        const int c = (r & 3) + 8 * (r >> 2);
        if ((unsigned)(dq - c) >= W) p0[r] = NEG;
        if ((unsigned)(dq - c - 32) >= W) p1[r] = NEG;
    }
}
__device__ __forceinline__ void partialSM(f32x16& p0, f32x16& p1, float& m_reg, float& mn, float& alpha, bool keep = true) {
    float pmax = p0[0]; for (int r = 1; r < 16; ++r) pmax = fmaxf(pmax, p0[r]); for (int r = 0; r < 16; ++r) pmax = fmaxf(pmax, p1[r]);
    { auto rr = __builtin_amdgcn_permlane32_swap(__float_as_uint(pmax), __float_as_uint(pmax), false, false);
      pmax = fmaxf(__uint_as_float(rr[0]), __uint_as_float(rr[1])); }
    pmax = keep ? pmax : -__builtin_inff();
    constexpr float C2 = 1.4426950408889634f * SCALE;
    if (__builtin_expect(__all((pmax - m_reg) * SCALE <= THR), 1)) { mn = m_reg; alpha = 1.f; }
    else { mn = fmaxf(m_reg, pmax); alpha = __builtin_amdgcn_exp2f((m_reg - mn) * C2); m_reg = mn; }
    const float mnL = keep ? -mn * C2 : -__builtin_inff(), c2 = keep ? C2 : 0.f;
    for (int r = 0; r < 16; ++r) p0[r] = fmaf(p0[r], c2, mnL); for (int r = 0; r < 16; ++r) p1[r] = fmaf(p1[r], c2, mnL);
    for (int r = 0; r < 16; ++r) p0[r] = __builtin_amdgcn_exp2f(p0[r]);
}
__device__ __forceinline__ void finishSM(f32x16& p0, f32x16& p1, float alpha, float& l_reg, bf16x8& pa0, bf16x8& pa1, bf16x8& pa2, bf16x8& pa3) {
    for (int r = 0; r < 16; ++r) p1[r] = __builtin_amdgcn_exp2f(p1[r]);
    float ps = 0; for (int r = 0; r < 16; ++r) ps += p0[r]; for (int r = 0; r < 16; ++r) ps += p1[r];
    { auto rr = __builtin_amdgcn_permlane32_swap(__float_as_uint(ps), __float_as_uint(ps), false, false);
      ps = __uint_as_float(rr[0]) + __uint_as_float(rr[1]); }
    l_reg = l_reg * alpha + ps;
#define PK4(P, B_, OUT) do { unsigned a0 = cvtpk(P[B_+0], P[B_+1]), a1 = cvtpk(P[B_+2], P[B_+3]);                          \
        unsigned b0 = cvtpk(P[B_+4], P[B_+5]), b1 = cvtpk(P[B_+6], P[B_+7]);                                             \
        auto r0 = __builtin_amdgcn_permlane32_swap(a0, b0, false, false); auto r1 = __builtin_amdgcn_permlane32_swap(a1, b1, false, false); \
        u32x4 w = {r0[0], r1[0], r0[1], r1[1]}; OUT = *reinterpret_cast<bf16x8*>(&w); } while (0)
    PK4(p0, 0, pa0); PK4(p0, 8, pa1); PK4(p1, 0, pa2); PK4(p1, 8, pa3);
#undef PK4
}
template <int KB, bool SK>
__device__ __forceinline__ void qkt(f32x16& p0, f32x16& p1, const char* K_lds, int r32, int hi, const bf16x8* qr, bool act) {
    if (SK && !act) { const float NEG = -__builtin_inff();
#pragma unroll
        for (int r = 0; r < 16; ++r) { p0[r] = NEG; p1[r] = NEG; } return; }
    p0 = f32x16{}; p1 = f32x16{};
    const char* kb[4];
#pragma unroll
    for (int dd = 0; dd < 4; ++dd) kb[dd] = K_lds + KB * SHM_K + KSWZ(r32, (dd * 16 + hi * 8) * 2);
#pragma unroll
    for (int d0 = 0; d0 < 8; ++d0) { const char* a = kb[d0 & 3] + (d0 >> 2) * 128;
        bf16x8 b0 = *reinterpret_cast<const bf16x8*>(a);
        bf16x8 b1 = *reinterpret_cast<const bf16x8*>(a + 32 * 256);
        p0 = __builtin_amdgcn_mfma_f32_32x32x16_bf16(b0, qr[d0], p0, 0, 0, 0);
        p1 = __builtin_amdgcn_mfma_f32_32x32x16_bf16(b1, qr[d0], p1, 0, 0, 0); }
}
template <int VB, bool SK>
__device__ __forceinline__ void pv_tile(f32x16* o, int vb0, bf16x8 pa0, bf16x8 pa1, bf16x8 pa2, bf16x8 pa3, bool act) {
    if (SK && !act) return;
#define TRRD(dst, off) asm volatile("ds_read_b64_tr_b16 %0, %1 offset:%2" : "=&v"(dst) : "v"(vb0), "i"(off) : "memory")
#define PV_D0(d0) do { s16x4 l0, l1, l2, l3, h0, h1, h2, h3; constexpr int b_ = VB * SHM_V + v_rd_off(d0, 0, 0);     \
        TRRD(l0, b_); TRRD(h0, b_ + 2048); TRRD(l1, b_ + 4096); TRRD(h1, b_ + 6144); TRRD(l2, b_ + 8192); TRRD(h2, b_ + 10240); TRRD(l3, b_ + 12288); TRRD(h3, b_ + 14336); \
        asm volatile("s_waitcnt lgkmcnt(0)" ::: "memory"); SBAR();                 \
        o[d0] = __builtin_amdgcn_mfma_f32_32x32x16_bf16(pa0, (bf16x8){l0[0], l0[1], l0[2], l0[3], h0[0], h0[1], h0[2], h0[3]}, o[d0], 0, 0, 0);   \
        o[d0] = __builtin_amdgcn_mfma_f32_32x32x16_bf16(pa1, (bf16x8){l1[0], l1[1], l1[2], l1[3], h1[0], h1[1], h1[2], h1[3]}, o[d0], 0, 0, 0);   \
        o[d0] = __builtin_amdgcn_mfma_f32_32x32x16_bf16(pa2, (bf16x8){l2[0], l2[1], l2[2], l2[3], h2[0], h2[1], h2[2], h2[3]}, o[d0], 0, 0, 0);   \
        o[d0] = __builtin_amdgcn_mfma_f32_32x32x16_bf16(pa3, (bf16x8){l3[0], l3[1], l3[2], l3[3], h3[0], h3[1], h3[2], h3[3]}, o[d0], 0, 0, 0); } while (0)
    PV_D0(0); PV_D0(1); PV_D0(2); PV_D0(3);
#undef PV_D0
#undef TRRD
}

template <class TIn, class TOut> struct BlockRef { const TIn* Q; const TIn* K; const TIn* V; TOut* O; int P0; const float* KM; };
template <class TIn> struct Seam {
    bf16x8 qr[8];
    bf16x8 st_v0, st_v1, st_k0, st_k1; f32x4 sf0, sf1, sf2, sf3;
    f32x4 tq[16];
};
__device__ __forceinline__ int swa_jlo(int P0, int W) { const int lowk = P0 - W + 1; return lowk > 0 ? lowk / KVBLK : 0; }
#define ROW(p, k0, rr) ((p) + (size_t)((k0) + (rr)) * D + sc)
#define VMW() asm volatile("s_waitcnt vmcnt(0)" ::: "memory")
#define VMWN(n) asm volatile("s_waitcnt vmcnt(%0)" :: "i"(n) : "memory")
#define SLOAD_H(Kp, Vp, k0) do { S.st_v0 = load8<TIn>(ROW(Vp, k0, sr)); S.st_v1 = load8<TIn>(ROW(Vp, k0, 32 + sr));              \
                         S.st_k0 = load8<TIn>(ROW(Kp, k0, sr)); S.st_k1 = load8<TIn>(ROW(Kp, k0, 32 + sr)); } while (0)
#define SWRITE_HK(bf) do { *(bf16x8*)(K_lds + (bf) * SHM_K + kws) = S.st_k0; *(bf16x8*)(K_lds + (bf) * SHM_K + kws + 32 * 256) = S.st_k1; } while (0)
#define SWRITE_HV(bf) do { *(bf16x8*)(V_lds + (bf) * SHM_V + vst0) = S.st_v0; *(bf16x8*)(V_lds + (bf) * SHM_V + vst1) = S.st_v1; } while (0)
#define SWRITE_H(bf) do { SWRITE_HV(bf); SWRITE_HK(bf); } while (0)
#define SLOAD_F(p, k0) do { S.sf0 = *(const f32x4*)ROW(p, k0, sr); S.sf1 = *(const f32x4*)(ROW(p, k0, sr) + 4);                \
                            S.sf2 = *(const f32x4*)ROW(p, k0, 32 + sr); S.sf3 = *(const f32x4*)(ROW(p, k0, 32 + sr) + 4); } while (0)
#define SWRITE_KF(bf) do { *(bf16x8*)(K_lds + (bf) * SHM_K + kws) = pack8(S.sf0, S.sf1); *(bf16x8*)(K_lds + (bf) * SHM_K + kws + 32 * 256) = pack8(S.sf2, S.sf3); } while (0)
#define SWRITE_VF(bf) do { *(bf16x8*)(V_lds + (bf) * SHM_V + vst0) = pack8(S.sf0, S.sf1); *(bf16x8*)(V_lds + (bf) * SHM_V + vst1) = pack8(S.sf2, S.sf3); } while (0)
template <class TIn, class TOut>
__device__ __forceinline__ void causal_swa_prime(const BlockRef<TIn, TOut>& cur, int W, char* lds, Seam<TIn>& S) {
    constexpr bool F32 = same_t<TIn, float>::v;
    const int tid = fresh_tid(), wid = __builtin_amdgcn_readfirstlane(tid >> 6), lane = tid & 63, r32 = lane & 31, hi = lane >> 5;
    const int sr = tid >> 4, sc = (tid & 15) * 8, kws = KSWZ(sr, sc * 2); char* K_lds = lds + 2 * SHM_V;
    const int kb0 = swa_jlo(cur.P0, W) * KVBLK;
    for (int d0 = 0; d0 < 8; ++d0) S.qr[d0] = load8<TIn>(cur.Q + (size_t)(wid * QBLK + r32) * D + d0 * 16 + hi * 8);
    if constexpr (F32) { SLOAD_F((const float*)cur.K, kb0); VMW(); SWRITE_KF(0); SBAR(); SLOAD_F((const float*)cur.V, kb0); }
    else { SLOAD_H(cur.K, cur.V, kb0); VMW(); SWRITE_HK(0); }
    __syncthreads();
}
template <class TIn, class TOut>
__device__ __forceinline__ void causal_swa_block(const BlockRef<TIn, TOut>& cur, const BlockRef<TIn, TOut>& nxt, int skv, int W, char* lds, Seam<TIn>& S) {
    constexpr bool F32 = same_t<TIn, float>::v;
    const int tid = fresh_tid(), wid = __builtin_amdgcn_readfirstlane(tid >> 6), lane = tid & 63, r32 = lane & 31, hi = lane >> 5;
    const int j_lo = swa_jlo(cur.P0, W);
    int j_hi = (cur.P0 + QB - 1) / KVBLK + 1; if (j_hi > skv / KVBLK) j_hi = skv / KVBLK;
    const int NT = j_hi - j_lo;
    const int kbn = swa_jlo(nxt.P0, W) * KVBLK;
    const int qlo = cur.P0 + wid * QBLK, qm = qlo + r32 - 4 * hi;
    char* V_lds = lds; char* K_lds = lds + 2 * SHM_V;
    float* ws = (float*)(lds + 2 * SHM_V + 2 * SHM_K) + wid * 64; float* li_l = ws, * al_l = ws + 32;
    { const unsigned sb_ = moba_select(S.qr, (const __attribute__((address_space(3))) float*)(lds + LDS_BYTES + 4096), cur.P0 >> 8, hi); ((unsigned*)(lds + LDS_BYTES))[tid] = sb_; }
    float m_reg = -1e30f, l_reg = 0; f32x16 o[4] = {};
    const int sr = tid >> 4, sc = (tid & 15) * 8, vst0 = v_st(sr, sc), vst1 = v_st(32 + sr, sc), kws = KSWZ(sr, sc * 2);
    const int vb0 = (int)(uintptr_t)V_lds + v_rd_base(lane);
    const TIn* Kh = cur.K; const TIn* Vh = cur.V;
#define RESC(a) do { if (__any((a) < 1.f)) { if (hi == 0) al_l[r32] = (a); asm volatile("s_waitcnt lgkmcnt(0)" ::: "memory");              \
                     for (int d_ = 0; d_ < 4; ++d_) for (int r = 0; r < 16; ++r) o[d_][r] *= al_l[crow(r, hi)]; } } while (0)
#define KBASE(t) ((j_lo + (t)) * KVBLK)
#define ACT(t) (KBASE(t) <= qlo + QBLK - 1 && KBASE(t) + KVBLK - 1 >= qlo - W + 1)
#define MASKT(P0_, P1_, t) do { const int kb_ = KBASE(t); keepT = true; \
        if (kb_ < cur.P0) { const unsigned selbits = ((const unsigned*)(lds + LDS_BYTES))[tid]; keepT = (selbits >> (kb_ >> 8)) & 1u; }     \
        else if (kb_ + KVBLK - 1 > qlo) mask_tile(P0_, P1_, qm - kb_, (unsigned)W); } while (0)
    constexpr int NQL = F32 ? 16 : 8;
    constexpr bool SK = WSKIP && !F32;
#define SEAM_K0() do { VMWN(NQL); if constexpr (F32) { SWRITE_KF(0); SBAR(); SLOAD_F((const float*)nxt.V, kbn); } else { SWRITE_HK(0); } SBAR(); } while (0)
    f32x16 pA0, pA1, pB0, pB1; float mnA, mnB, alA, alB; bf16x8 pa0, pa1, pa2, pa3;
    if constexpr (F32) { VMW(); SWRITE_VF(0); SBAR(); } else { SWRITE_HV(0); SBAR(); }
    if (NT > 1) { if constexpr (F32) SLOAD_F((const float*)Kh, KBASE(1)); else SLOAD_H(Kh, Vh, KBASE(1)); }
    SBAR(); qkt<0, SK>(pA0, pA1, K_lds, r32, hi, S.qr, ACT(0));
    if constexpr (F32) { if (NT > 1) { VMW(); SWRITE_KF(1); SBAR(); SLOAD_F((const float*)Vh, KBASE(1)); } }
    bool keepT = true;
    MASKT(pA0, pA1, 0); partialSM(pA0, pA1, m_reg, mnA, alA, keepT);
    if (NT > 1) { VMW(); if constexpr (F32) { SWRITE_VF(1); SBAR(); if (NT > 2) SLOAD_F((const float*)Kh, KBASE(2)); } else SWRITE_H(1); }
    __syncthreads();
#define HALF_STEP(PX0, PX1, mnX, alX, PY0, PY1, alY, t, KB, VB, SB) do {                                                      \
        SBAR(); qkt<KB, SK>(PX0, PX1, K_lds, r32, hi, S.qr, ACT(t));                                             \
        finishSM(PY0, PY1, alY, l_reg, pa0, pa1, pa2, pa3); SBAR();                                                           \
        if ((t) + 1 < NT) { if constexpr (F32) { VMW(); SWRITE_KF(SB); SBAR(); SLOAD_F((const float*)Vh, KBASE((t) + 1)); }  \
                            else { SLOAD_H(Kh, Vh, KBASE((t) + 1)); } SBAR(); }                                               \
        pv_tile<VB, SK>(o, vb0, pa0, pa1, pa2, pa3, ACT((t) - 1)); MASKT(PX0, PX1, (t)); partialSM(PX0, PX1, m_reg, mnX, alX, keepT);                                        \
        __syncthreads();                                                                                                      \
        if ((t) + 1 < NT) { VMW(); if constexpr (F32) { SWRITE_VF(SB); SBAR(); if ((t) + 2 < NT) SLOAD_F((const float*)Kh, KBASE((t) + 2)); } \
                            else { SWRITE_H(SB); } }                                                                          \
        RESC(alX); __syncthreads(); } while (0)
    for (int t = 1; t + 1 < NT; t += 2) {
        HALF_STEP(pB0, pB1, mnB, alB, pA0, pA1, alA, t, 1, 0, 0);
        HALF_STEP(pA0, pA1, mnA, alA, pB0, pB1, alB, t + 1, 0, 1, 1);
    }
    const bool even = (NT & 1) == 0;
    if (even) { SBAR(); qkt<1, SK>(pB0, pB1, K_lds, r32, hi, S.qr, ACT(NT - 1)); SBAR(); }
#define QROW(e) (nxt.Q + (size_t)(wid * QBLK + r32) * D + ((e) >> 1) * 16 + hi * 8 + ((e) & 1) * 4)
    if constexpr (F32) { SLOAD_F((const float*)nxt.K, kbn); SBAR();
#pragma unroll
        for (int e = 0; e < 8; ++e) S.tq[e] = *(const f32x4*)QROW(e); }
    else { int sr_ = sr, sc_ = sc; asm volatile("" : "+v"(sr_), "+v"(sc_)); { const int sr = sr_, sc = sc_; SLOAD_H(nxt.K, nxt.V, kbn); } SBAR();
#pragma unroll
        for (int d0 = 0; d0 < 8; ++d0) S.qr[d0] = load8<TIn>(nxt.Q + (size_t)(wid * QBLK + r32) * D + d0 * 16 + hi * 8); }
    SBAR();
    finishSM(pA0, pA1, alA, l_reg, pa0, pa1, pa2, pa3); SBAR();
    if constexpr (F32) {
#pragma unroll
        for (int e = 8; e < 16; ++e) S.tq[e] = *(const f32x4*)QROW(e); SBAR(); }
#undef QROW
    pv_tile<0, SK>(o, vb0, pa0, pa1, pa2, pa3, ACT(even ? NT - 2 : NT - 1));
    if (even) { MASKT(pB0, pB1, NT - 1); partialSM(pB0, pB1, m_reg, mnB, alB, keepT); __syncthreads(); RESC(alB);
        finishSM(pB0, pB1, alB, l_reg, pa0, pa1, pa2, pa3); SBAR(); pv_tile<1, SK>(o, vb0, pa0, pa1, pa2, pa3, ACT(NT - 1)); }
    SBAR(); SEAM_K0();
    if (hi == 0) li_l[r32] = l_reg; asm volatile("s_waitcnt lgkmcnt(0)" ::: "memory");
    float rli[16];
#pragma unroll
    for (int r = 0; r < 16; ++r) rli[r] = __builtin_amdgcn_rcpf(li_l[crow(r, hi)]);
    unsigned char* Ow8 = (unsigned char*)cur.O + (size_t)(wid * QBLK) * OSTR;
#pragma unroll
    for (int r = 0; r < 16; ++r) { const int orow = crow(r, hi);
#pragma unroll
        for (int d0 = 0; d0 < 4; ++d0) { const float v = o[d0][r] * rli[r];
            const float v64 = v * 64.0f, vb = __shfl_xor(v64, 1), vc = __shfl_xor(v64, 2), vd = __shfl_xor(vb, 2);
            if ((r32 & 3) == 0) *(unsigned*)(Ow8 + (size_t)orow * OSTR + d0 * 32 + r32) = pk4_fp8(v64, vb, vc, vd); } }
    if constexpr (F32) {
#pragma unroll
        for (int d0 = 0; d0 < 8; ++d0) S.qr[d0] = pack8(S.tq[2 * d0], S.tq[2 * d0 + 1]); }
    __syncthreads();
#undef RESC
#undef KBASE
#undef ACT
#undef MASKT
#undef SEAM_K0
#undef HALF_STEP
}
#undef ROW
#undef VMW
#undef VMWN
#undef SLOAD_H
#undef SWRITE_HK
#undef SWRITE_HV
#undef SWRITE_H
#undef SLOAD_F
#undef SWRITE_KF
#undef SWRITE_VF

#undef KSWZ
#undef SBAR
}

__device__ __forceinline__ void attn_phase(Frame& F) {
    if (F.bid >= 144) return;
    typedef att::BlockRef<bf16, bf16> Ref;
    const int bh = F.bid & 15, y = F.bid >> 4, b = bh >> 3, h = bh & 7;
    const bf16* MQ = wsp<bf16>(F, WS_MQ) + (size_t)bh * 4096 * 128; const bf16* MK = wsp<bf16>(F, WS_MK) + (size_t)bh * 4096 * 128; const bf16* MV = wsp<bf16>(F, WS_MV) + (size_t)bh * 4096 * 128;
    bf16* OA = (bf16*)(F.ws + WS_OA + (size_t)b * 4096 * 1024 + h * 128);        const float* KM = wsp<float>(F, OFF_KMEAN) + (size_t)bh * 16 * 128;
    const bool single = (y == 0) || (y == 8); const int q0 = y == 0 ? 15 : (y == 8 ? 7 : y - 1), q1 = single ? q0 : 15 - y;
    const Ref r0{MQ + (size_t)q0 * 256 * 128, MK, MV, (bf16*)((unsigned char*)OA + (size_t)q0 * 256 * 1024), q0 * 256, KM};
    const Ref r1{MQ + (size_t)q1 * 256 * 128, MK, MV, (bf16*)((unsigned char*)OA + (size_t)q1 * 256 * 1024), q1 * 256, KM};
    att::Seam<bf16> S;
    char* lds = (char*)F.ldsg;
    ((LAS f32x4*)(F.lds + att::LDS_BYTES + 4096))[F.tid] = ((const GAS f32x4*)KM)[F.tid] + ((const GAS f32x4*)(wsp<float>(F, WS_KMEAN1) + (size_t)bh * 16 * 128))[F.tid];
    __syncthreads();
    att::causal_swa_prime<bf16, bf16>(r0, 1 << 30, lds, S);
    att::causal_swa_block<bf16, bf16>(r0, r1, 4096, 1 << 30, lds, S);
    if (!single) att::causal_swa_block<bf16, bf16>(r1, r1, 4096, 1 << 30, lds, S);
    VM_WAIT(); __syncthreads();
}


namespace ret {
constexpr int PITCH = 272, TILE = 128 * PITCH;
constexpr int QS = 0, KS = TILE, PS = 2 * TILE, ST = 3 * TILE, YT = 0, YPITCH = 528;
static_assert(128 * YPITCH <= 2 * TILE && ST + 8192 <= RING_BYTES, "retention LDS map");
typedef short s16x4 __attribute__((ext_vector_type(4)));
typedef short v4i16_t __attribute__((ext_vector_type(4)));
__device__ __forceinline__ s16x4 vtr(LAS const unsigned char* p) { return __builtin_bit_cast(s16x4, __builtin_amdgcn_ds_read_tr16_b64_v4i16((LAS v4i16_t*)p)); }
#define RMFMA(a, b, c) __builtin_amdgcn_mfma_f32_32x32x16_bf16((a), (b), (c), 0, 0, 0)
__device__ __forceinline__ bf16x8 pack_step(const f32x16& x, int s) {
    u32x4 w; w.x = pk2(x[8 * s], x[8 * s + 1]); w.y = pk2(x[8 * s + 2], x[8 * s + 3]); w.z = pk2(x[8 * s + 4], x[8 * s + 5]); w.w = pk2(x[8 * s + 6], x[8 * s + 7]);
    return __builtin_bit_cast(bf16x8, w);
}
__device__ __forceinline__ void retention_item(Frame& F, const Args& A, int bh, int seg) {
    LAS unsigned char* lds = F.lds;
    const int tid = F.tid, lane = F.lane, w = F.wave, r = lane & 31, h = lane >> 5;
    const int head = bh & 7, b = bh >> 3;
    const bf16* RQ = wsp<bf16>(F, WS_RQ) + (size_t)bh * 4096 * 128; const bf16* RK = wsp<bf16>(F, WS_RK) + (size_t)bh * 4096 * 128;
    const bf16* RVT = wsp<bf16>(F, WS_RVT) + ((size_t)bh * 256 + 32 * w + r) * 4096 + 8 * h;
    const bf16* RG = wsp<bf16>(F, WS_RG); bf16* YR = wsp<bf16>(F, WS_YR);
    const float nlg = -log2f(1.0f - exp2f(-(5.0f + (float)head)));
    const float cd = exp2f(-128.0f * nlg);
    f32x16 R[4];
#pragma unroll
    for (int d = 0; d < 4; ++d)
#pragma unroll
        for (int i = 0; i < 16; ++i) R[d][i] = 0.f;
    const int n0 = seg == 0 ? 0 : (seg == 1 ? 11 : (seg == 2 ? 20 : 27)), nend = seg == 0 ? 11 : (seg == 1 ? 20 : (seg == 2 ? 27 : 32));
    u32x4 stq[4], stk[4];
    const int srow = tid >> 4, sch = tid & 15;
    const unsigned swr = (unsigned)(srow * PITCH + sch * 16);
#define RLOADK(n) do { _Pragma("unroll") for (int k_ = 0; k_ < 4; ++k_) stk[k_] = *(const GAS u32x4*)(RK + ((size_t)(n) * 128 + srow + 32 * k_) * 128 + sch * 8); } while (0)
#define RLOADQ(n) do { _Pragma("unroll") for (int k_ = 0; k_ < 4; ++k_) stq[k_] = __builtin_nontemporal_load((const GAS u32x4*)(RQ + ((size_t)(n) * 128 + srow + 32 * k_) * 128 + sch * 8)); } while (0)
#define RWRITEK() do { _Pragma("unroll") for (int k_ = 0; k_ < 4; ++k_) *(LAS u32x4*)(lds + KS + swr + k_ * 32 * PITCH) = stk[k_]; } while (0)
#define RWRITEQ() do { _Pragma("unroll") for (int k_ = 0; k_ < 4; ++k_) *(LAS u32x4*)(lds + QS + swr + k_ * 32 * PITCH) = stq[k_]; } while (0)
    RLOADK(0); if (n0 == 0) RLOADQ(0);
    RWRITEK(); if (n0 == 0) RWRITEQ();
    __syncthreads();
    const int d8 = tid & 31; f32x4 gw0, gw1;
    { const GAS f32x4* gp = (const GAS f32x4*)(A.in[I_GN_W] + head * 256 + d8 * 8); gw0 = gp[0]; gw1 = gp[1]; }
    const unsigned nat = (unsigned)(r * PITCH + h * 16), prm = (unsigned)(r * PITCH + h * 8);
    const unsigned trb = (unsigned)((8 * h + ((lane & 15) >> 2)) * PITCH + ((lane >> 4) & 1) * 32 + (lane & 3) * 8);
#define RVLOAD(n) do { _Pragma("unroll") for (int ks = 0; ks < 8; ++ks) vfr[ks] = *(const GAS bf16x8*)(RVT + (size_t)(n) * 128 + ks * 16); } while (0)
#define RUPDATE() do { _Pragma("unroll") for (int d = 0; d < 4; ++d) { \
            _Pragma("unroll") for (int ks = 0; ks < 8; ++ks) { LAS const unsigned char* kp = lds + KS + trb + ks * 16 * PITCH + d * 64; \
                const s16x4 lo = vtr(kp); const s16x4 hi4 = vtr(kp + 4 * PITCH); \
                const bf16x8 ka = __builtin_shufflevector(lo, hi4, 0, 1, 2, 3, 4, 5, 6, 7); \
                R[d] = RMFMA(ka, vfr[ks], R[d]); if ((ks & 3) == 3) __builtin_amdgcn_sched_barrier(0); } \
            _Pragma("unroll") for (int i = 0; i < 16; ++i) R[d][i] *= cd; \
            __builtin_amdgcn_sched_barrier(0); } } while (0)
    for (int n = 0; n < n0; ++n) {
        bf16x8 vfr[8]; RVLOAD(n);
        RUPDATE();
        __builtin_amdgcn_sched_barrier(0);
        RLOADK(n + 1); if (n + 1 == n0) RLOADQ(n + 1);
        __syncthreads();
        RWRITEK(); if (n + 1 == n0) RWRITEQ();
        __syncthreads();
    }
    for (int n = n0; n < nend; ++n) {
        const bool has_next = (n + 1) < nend;
        bf16x8 vfr[8]; RVLOAD(n);
        f32x16 O[4];
        {
            const int it = w >> 1;
#pragma unroll
            for (int jj = 0; jj < 2; ++jj) { const int jt = 2 * (w & 1) + jj;
                if (jt <= it) {
                    f32x16 x;
#pragma unroll
                    for (int i = 0; i < 16; ++i) x[i] = 0.f;
                    LAS const unsigned char* ka = lds + KS + nat + jt * 32 * PITCH; LAS const unsigned char* qa = lds + QS + nat + it * 32 * PITCH;
#pragma unroll
                    for (int s = 0; s < 8; ++s) { const bf16x8 a = *(const LAS bf16x8*)(ka + s * 32); const bf16x8 bq = *(const LAS bf16x8*)(qa + s * 32); x = RMFMA(a, bq, x); }
                    if (jt == it) {
#pragma unroll
                        for (int i = 0; i < 16; ++i) { const int jl = (i & 3) + 8 * (i >> 2) + 4 * h; x[i] = jl <= r ? x[i] : 0.f; } }
                    LAS unsigned char* pw = lds + PS + prm + it * 32 * PITCH + jt * 64;
#pragma unroll
                    for (int g = 0; g < 4; ++g) { u32x2 v; v.x = pk2(x[4 * g], x[4 * g + 1]); v.y = pk2(x[4 * g + 2], x[4 * g + 3]); *(LAS u32x2*)(pw + g * 16) = v; }
                } }
            __syncthreads();
#pragma unroll
            for (int t = 0; t < 4; ++t)
#pragma unroll
                for (int i = 0; i < 16; ++i) O[t][i] = 0.f;
#pragma unroll
            for (int t = 0; t < 4; ++t)
#pragma unroll
                for (int kx = 0; kx < 8; ++kx) if (kx < 2 * t + 2) { const bf16x8 pb = *(const LAS bf16x8*)(lds + PS + nat + t * 32 * PITCH + kx * 32); O[t] = RMFMA(vfr[kx], pb, O[t]); if (kx & 1) __builtin_amdgcn_sched_barrier(0); }
#pragma unroll
            for (int d = 0; d < 4; ++d)
#pragma unroll
                for (int s = 0; s < 2; ++s) { const bf16x8 ra = pack_step(R[d], s);
#pragma unroll
                    for (int t = 0; t < 4; ++t) { LAS const unsigned char* qp = lds + QS + prm + t * 32 * PITCH + d * 64 + s * 32; const u32x2 lo = *(const LAS u32x2*)qp, hi2 = *(const LAS u32x2*)(qp + 16);
                        u32x4 qb; qb.x = lo.x; qb.y = lo.y; qb.z = hi2.x; qb.w = hi2.y; O[t] = RMFMA(ra, __builtin_bit_cast(bf16x8, qb), O[t]); }
                    __builtin_amdgcn_sched_barrier(0); }
        }
        RUPDATE();
        __builtin_amdgcn_sched_barrier(0);
        if (has_next) { RLOADK(n + 1); RLOADQ(n + 1); }
        {
            LAS float* st = (LAS float*)(lds + ST);
#pragma unroll
            for (int t = 0; t < 4; ++t) { const float sc = exp2f(-(float)(32 * t + r + 1) * nlg); float s1 = 0.f, s2 = 0.f;
#pragma unroll
                for (int i = 0; i < 16; ++i) { O[t][i] *= sc; s1 += O[t][i]; s2 = fmaf(O[t][i], O[t][i], s2); }
                s1 += __shfl_xor(s1, 32); s2 += __shfl_xor(s2, 32);
                if (h == 0) { st[(w * 128 + 32 * t + r) * 2] = s1; st[(w * 128 + 32 * t + r) * 2 + 1] = s2; } }
        }
        __syncthreads();
        {
            const LAS float* st = (const LAS float*)(lds + ST);
#pragma unroll
            for (int t = 0; t < 4; ++t) { float s1 = 0.f, s2 = 0.f;
#pragma unroll
                for (int ww = 0; ww < 8; ++ww) { s1 += st[(ww * 128 + 32 * t + r) * 2]; s2 += st[(ww * 128 + 32 * t + r) * 2 + 1]; }
                const float mu = s1 * (1.0f / 256.0f), var = fmaxf(s2 * (1.0f / 256.0f) - mu * mu, 0.f), rstd = 1.0f / sqrtf(var + GN_EPS);
                LAS unsigned char* yw = lds + YT + (32 * t + r) * YPITCH + (32 * w + 4 * h) * 2;
#pragma unroll
                for (int g = 0; g < 4; ++g) { u32x2 v; v.x = pk2((O[t][4 * g] - mu) * rstd, (O[t][4 * g + 1] - mu) * rstd); v.y = pk2((O[t][4 * g + 2] - mu) * rstd, (O[t][4 * g + 3] - mu) * rstd);
                    *(LAS u32x2*)(yw + g * 16) = v; } }
            __syncthreads();
            const size_t tok0 = (size_t)b * 4096 + (size_t)n * 128;
#pragma unroll
            for (int k_ = 0; k_ < 8; ++k_) { const int tl = (tid >> 5) + 16 * k_; const u32x4 y = *(const LAS u32x4*)(lds + YT + tl * YPITCH + d8 * 16);
                const size_t go = (tok0 + tl) * 2048 + head * 256 + d8 * 8; const u32x4 g = __builtin_nontemporal_load((const GAS u32x4*)(RG + go));
                f32x4 o0, o1; o0.x = bf_lo(y.x) * gw0.x * bf_lo(g.x); o0.y = bf_hi(y.x) * gw0.y * bf_hi(g.x); o0.z = bf_lo(y.y) * gw0.z * bf_lo(g.y); o0.w = bf_hi(y.y) * gw0.w * bf_hi(g.y);
                o1.x = bf_lo(y.z) * gw1.x * bf_lo(g.z); o1.y = bf_hi(y.z) * gw1.y * bf_hi(g.z); o1.z = bf_lo(y.w) * gw1.z * bf_lo(g.w); o1.w = bf_hi(y.w) * gw1.w * bf_hi(g.w);
                { u32x2 y8;
#define Y8C(v_) __builtin_amdgcn_fmed3f((v_) * 8.0f, -448.0f, 448.0f)
                  y8.x = pk4_fp8(Y8C(o0.x), Y8C(o0.y), Y8C(o0.z), Y8C(o0.w)); y8.y = pk4_fp8(Y8C(o1.x), Y8C(o1.y), Y8C(o1.z), Y8C(o1.w));
#undef Y8C
                  *(GAS u32x2*)((unsigned char*)YR + go) = y8; } }
            __syncthreads();
        }
        if (has_next) { RWRITEK(); RWRITEQ(); }
        __syncthreads();
    }
#undef RVLOAD
#undef RUPDATE
#undef RLOADK
#undef RLOADQ
#undef RWRITEK
#undef RWRITEQ
}
#undef RMFMA
}
__device__ __forceinline__ void retention_phase(Frame& F, const Args& A) {
    if (F.bid < 144 || F.bid >= 208) return;
    const int idx = F.bid - 144;
    ret::retention_item(F, A, idx & 15, idx >> 4);
}

struct SchedDense {
    static constexpr bool GATHER = false, LITE = false;
    int G, c; const char* ws; unsigned offA, offW, ts;
    __device__ __forceinline__ bool next(int i, Unit& u) const { const int L = i * G + c; if (L >= 256) return false; int pm, pn; pg8::tile_of(L, 32, 8, pm, pn); u.pm = pm; u.pn = pn; u.kind = 0; u.aux = 0; u.slot = i; return true; }
    __device__ __forceinline__ void ptrs(const Unit& u, unsigned& a, unsigned& b) const { a = offA + (unsigned)u.pm * ts; b = offW + (unsigned)u.pn * ts; }
    __device__ __forceinline__ int arow(int, int) const { return 0; }
};
struct EpiMixA {
    unsigned char* ws;
    __device__ __forceinline__ void operator()(AccRef acc, const Unit& u, int wr, int wc, int fr, int fq) const {
        asm volatile("" : "+v"(fr), "+v"(fq));
        const unsigned char* GA = ws + WS_GA; unsigned char* MIXA = ws + WS_MIXA;
#pragma unroll
        for (int ai = 0; ai < 2; ++ai)
#pragma unroll
            for (int m = 0; m < 4; ++m) { const size_t off = (size_t)(u.pm * 256 + ai * 128 + wr * 64 + m * 16 + fr) * 2048 + u.pn * 256 + wc * 64 + 16 * fq;
                const u32x4 g = *(const GAS u32x4*)(GA + off); u32x4 o;
#pragma unroll
                for (int bj = 0; bj < 2; ++bj) { const f32x4 g0 = unpk4_fp8(bj ? g.z : g.x), g1 = unpk4_fp8(bj ? g.w : g.y);
                    const f32x4 v0 = acc[ai][bj][m][0] * (1.0f / 32.0f) * g0, v1 = acc[ai][bj][m][1] * (1.0f / 32.0f) * g1;
                    const unsigned p0 = pk4_fp8(v0.x, v0.y, v0.z, v0.w), p1 = pk4_fp8(v1.x, v1.y, v1.z, v1.w);
                    if (bj) { o.z = p0; o.w = p1; } else { o.x = p0; o.y = p1; } }
                *(GAS u32x4*)(MIXA + off) = o; }
    }
};
constexpr float MIX_SCALE = 64.0f;
struct EpiMixB {
    unsigned char* ws;
    __device__ __forceinline__ void operator()(AccRef acc, const Unit& u, int wr, int wc, int fr, int fq) const {
        asm volatile("" : "+v"(fr), "+v"(fq));
        const bf16* GR = (const bf16*)(ws + WS_GR); const unsigned char* MIXA = ws + WS_MIXA; unsigned char* MIX = ws + WS_MIX;
#pragma unroll
        for (int ai = 0; ai < 2; ++ai)
#pragma unroll
            for (int m = 0; m < 4; ++m) { const size_t off = (size_t)(u.pm * 256 + ai * 128 + wr * 64 + m * 16 + fr) * 2048 + u.pn * 256 + wc * 64 + 16 * fq;
                const u32x4 a8 = *(const GAS u32x4*)(MIXA + off); u32x4 o;
#pragma unroll
                for (int bj = 0; bj < 2; ++bj) { const u32x4 g = *(const GAS u32x4*)(GR + off + bj * 8); const f32x4 a0 = unpk4_fp8(bj ? a8.z : a8.x) * (1.0f / 64.0f), a1 = unpk4_fp8(bj ? a8.w : a8.y) * (1.0f / 64.0f); f32x4 v0 = acc[ai][bj][m][0] * (1.0f / 256.0f), v1 = acc[ai][bj][m][1] * (1.0f / 256.0f);
                    v0.x = fmaf(v0.x, bf_lo(g.x), a0.x); v0.y = fmaf(v0.y, bf_hi(g.x), a0.y); v0.z = fmaf(v0.z, bf_lo(g.y), a0.z); v0.w = fmaf(v0.w, bf_hi(g.y), a0.w);
                    v1.x = fmaf(v1.x, bf_lo(g.z), a1.x); v1.y = fmaf(v1.y, bf_hi(g.z), a1.y); v1.z = fmaf(v1.z, bf_lo(g.w), a1.z); v1.w = fmaf(v1.w, bf_hi(g.w), a1.w);
#pragma unroll
                    for (int j = 0; j < 4; ++j) { v0[j] = __builtin_amdgcn_fmed3f(v0[j] * MIX_SCALE, -127.0f, 127.0f); v1[j] = __builtin_amdgcn_fmed3f(v1[j] * MIX_SCALE, -127.0f, 127.0f); }
                    const unsigned p0 = pk4_i8(v0.x, v0.y, v0.z, v0.w), p1 = pk4_i8(v1.x, v1.y, v1.z, v1.w); if (bj) { o.z = p0; o.w = p1; } else { o.x = p0; o.y = p1; } }
                *(GAS u32x4*)(MIX + off) = o; }
    }
};
struct EpiOut {
    const float* X; unsigned char* ws; bool skip_at;
    __device__ __forceinline__ void operator()(AccRef acc, const Unit& u, int wr, int wc, int fr, int fq) const {
        asm volatile("" : "+v"(fr), "+v"(fq));
        bf16* X1B = (bf16*)(ws + WS_X1B); float* SSQP = (float*)(ws + WS_SSQP);
#pragma unroll
        for (int ai = 0; ai < 2; ++ai)
#pragma unroll
            for (int m = 0; m < 4; ++m) { const int row = u.pm * 256 + ai * 128 + wr * 64 + m * 16 + fr; const size_t off = (size_t)row * 2048 + u.pn * 256 + wc * 32 + 8 * fq; float ss = 0.f;
#pragma unroll
                for (int bj = 0; bj < 2; ++bj) { const f32x4 x0 = *(const GAS f32x4*)(X + off + bj * 128), x1 = *(const GAS f32x4*)(X + off + bj * 128 + 4);
                    const f32x4 v0 = acc[ai][bj][m][0] * (1.0f / (MIX_SCALE * W_IN_SCALE)) + x0, v1 = acc[ai][bj][m][1] * (1.0f / (MIX_SCALE * W_IN_SCALE)) + x1;
                    *(GAS u32x4*)(X1B + off + bj * 128) = pack8(v0, v1);
                    { u32x2 o8; o8.x = pk4_fp8(v0.x, v0.y, v0.z, v0.w); o8.y = pk4_fp8(v1.x, v1.y, v1.z, v1.w); *(GAS u32x2*)(ws + WS_X1B8 + off + bj * 128) = o8; }
                    ss += (v0.x * v0.x + v0.y * v0.y) + (v0.z * v0.z + v0.w * v0.w) + (v1.x * v1.x + v1.y * v1.y) + (v1.z * v1.z + v1.w * v1.w); }
                ss += __shfl_xor(ss, 16); ss += __shfl_xor(ss, 32);
                if (fq == 0) SSQP[(size_t)(u.pn * 4 + wc) * 8192 + row] = ss; }
    }
};

__device__ __forceinline__ void router_phase(Frame& F, const Args& A) {
    const bf16* X1B = wsp<bf16>(F, WS_X1B); const bf16* WRT = wsp<bf16>(F, WS_WRT); const float* SSQP = wsp<float>(F, WS_SSQP);
    unsigned* CNT = wsp<unsigned>(F, OFF_CNT); unsigned* LISTTOK = wsp<unsigned>(F, WS_LISTTOK); float* LISTW = wsp<float>(F, WS_LISTW); float* RSTD = wsp<float>(F, WS_RSTD);
    LAS float* part = (LAS float*)F.lds;
    LAS float* logit = (LAS float*)(F.lds + 65536);
    LAS float* ssl = (LAS float*)(F.lds + 65536 + 8192);
    const int lane = F.lane, w = F.wave, r32 = lane & 31, hi = lane >> 5;
    for (int rt = F.bid; rt < T / 32; rt += F.G) {
        const int row0 = rt * 32;
        f32x16 a0, a1;
#pragma unroll
        for (int i = 0; i < 16; ++i) { a0[i] = 0.f; a1[i] = 0.f; }
        const bf16* ap = X1B + (size_t)(row0 + r32) * 2048 + w * 256 + hi * 8; const bf16* bp0 = WRT + (size_t)r32 * 2048 + w * 256 + hi * 8; const bf16* bp1 = bp0 + (size_t)32 * 2048;
#pragma unroll 8
        for (int ks = 0; ks < 16; ++ks) { const bf16x8 a = *(const GAS bf16x8*)(ap + ks * 16), b0 = *(const GAS bf16x8*)(bp0 + ks * 16), b1 = *(const GAS bf16x8*)(bp1 + ks * 16);
            a0 = __builtin_amdgcn_mfma_f32_32x32x16_bf16(a, b0, a0, 0, 0, 0); a1 = __builtin_amdgcn_mfma_f32_32x32x16_bf16(a, b1, a1, 0, 0, 0); }
#pragma unroll
        for (int i = 0; i < 16; ++i) { const int row = (i & 3) + 8 * (i >> 2) + 4 * hi; part[(w * 32 + row) * 64 + r32] = a0[i]; part[(w * 32 + row) * 64 + 32 + r32] = a1[i]; }
        { const int tk = F.tid & 31, pp = F.tid >> 5; ssl[pp * 32 + tk] = SSQP[(size_t)pp * 8192 + row0 + tk] + SSQP[(size_t)(pp + 16) * 8192 + row0 + tk]; }
        __syncthreads();
        for (int e = F.tid; e < 2048; e += 512) { float s = 0.f;
#pragma unroll
            for (int ww = 0; ww < 8; ++ww) s += part[ww * 2048 + e];
            logit[e] = s; }
        __syncthreads();
        if (F.tid < 32) {
            const int t = row0 + F.tid; const LAS float* lg = logit + F.tid * 64;
            float ssq = 0.f;
#pragma unroll
            for (int pp = 0; pp < 16; ++pp) ssq += ssl[pp * 32 + F.tid];
            const float rstd = 1.0f / sqrtf(ssq * (1.0f / DM) + RMS_EPS);
            float gl[4]; float gm = -__builtin_inff(); int gi = 0;
#pragma unroll
            for (int j = 0; j < 4; ++j) { gl[j] = lg[j] * rstd + A.in[I_B_RG][j]; if (gl[j] > gm) { gm = gl[j]; gi = j; } }
            float gs = 0.f;
#pragma unroll
            for (int j = 0; j < 4; ++j) gs += __expf(gl[j] - gm);
            const float gw = 1.0f / gs;
            float el[8]; float em = -__builtin_inff();
#pragma unroll
            for (int j = 0; j < 8; ++j) { el[j] = lg[4 + gi * 8 + j] * rstd + A.in[I_B_RE][gi * 8 + j]; em = fmaxf(em, el[j]); }
            int i1 = 0; float p1 = -1.f;
#pragma unroll
            for (int j = 0; j < 8; ++j) { el[j] = __expf(el[j] - em); if (el[j] > p1) { p1 = el[j]; i1 = j; } }
            int i2 = 0; float p2 = -1.f;
#pragma unroll
            for (int j = 0; j < 8; ++j) if (j != i1 && el[j] > p2) { p2 = el[j]; i2 = j; }
            const float inv = 1.0f / (p1 + p2);
            const int e1 = gi * 8 + i1, e2 = gi * 8 + i2;
            LAS unsigned* cl = (LAS unsigned*)(F.lds + MISC_OFF + 2304);
            volatile LAS unsigned* clv = cl;
            clv[F.tid] = 0u; __builtin_amdgcn_wave_barrier();
            const unsigned r1 = __hip_atomic_fetch_add(cl + e1, 1u, __ATOMIC_RELAXED, __HIP_MEMORY_SCOPE_WORKGROUP), r2 = __hip_atomic_fetch_add(cl + e2, 1u, __ATOMIC_RELAXED, __HIP_MEMORY_SCOPE_WORKGROUP);
            __builtin_amdgcn_wave_barrier();
            { const unsigned c_ = clv[F.tid]; clv[32 + F.tid] = c_ ? atomicAdd(CNT + (rt & 15) * 32 + F.tid, c_) : 0u; }
            __builtin_amdgcn_wave_barrier();
            const unsigned q1 = (unsigned)(rt & 15) * 512u + clv[32 + e1] + r1, q2 = (unsigned)(rt & 15) * 512u + clv[32 + e2] + r2;
            LISTTOK[e1 * 8192 + q1] = (unsigned)t; LISTW[e1 * 8192 + q1] = gw * p1 * inv;
            LISTTOK[e2 * 8192 + q2] = (unsigned)t | 0x10000u; LISTW[e2 * 8192 + q2] = gw * p2 * inv;
            RSTD[t] = rstd;
        }
        __syncthreads();
    }
}

constexpr int PRE_OFF = MISC_OFF + 10240;
__device__ __forceinline__ void build_tables(Frame& F) {
    LAS int* tb = (LAS int*)(F.lds + MISC_OFF); LAS int* cg = (LAS int*)(F.lds + PRE_OFF); LAS int* pre = cg + 512;
    { const unsigned* CNT = wsp<unsigned>(F, OFF_CNT); cg[(F.tid & 31) * 16 + (F.tid >> 5)] = (int)__hip_atomic_load(CNT + F.tid, __ATOMIC_RELAXED, __HIP_MEMORY_SCOPE_AGENT); }
    __syncthreads();
    if (F.tid < 64) { const int e = F.tid & 31; int c = 0;
#pragma unroll
        for (int g = 0; g < 16; ++g) { if (F.tid < 32) pre[e * 16 + g] = c; c += cg[e * 16 + g]; }
        const int pc = (c + 255) & ~255;
        int incl = pc;
#pragma unroll
        for (int o = 1; o < 32; o <<= 1) { const int t = __shfl_up(incl, o, 32); if (e >= o) incl += t; }
        const int rem = c & 255, lt = (rem != 0 && rem <= 128) ? 1 : 0, fl = (pc >> 8) - lt; int fi = fl, li = lt;
#pragma unroll
        for (int o = 1; o < 32; o <<= 1) { const int t1 = __shfl_up(fi, o, 32), t2 = __shfl_up(li, o, 32); if (e >= o) { fi += t1; li += t2; } }
        if (F.tid < 32) { tb[e] = c; tb[32 + e] = incl - pc; tb[72 + e] = fi - fl; tb[112 + e] = li - lt; if (e == 31) { tb[64] = incl; tb[104] = fi; tb[144] = li; } } }
    __syncthreads();
}
__device__ __forceinline__ int list_pos(const LAS int* pre, int e, int idx) {
    int g = 0;
#pragma unroll
    for (int k = 1; k < 16; ++k) if (idx >= pre[e * 16 + k]) g = k;
    return e * 8192 + g * 512 + (idx - pre[e * 16 + g]);
}
constexpr int TOKT_OFF = MISC_OFF + 4096, TOKT_UNITS = 6;
template <bool GATH> struct SchedExpert {
    static constexpr bool GATHER = GATH, LITE = GATH;
    int G, c, NT; const char* ws; unsigned offA, offW, tsA, tsW; int wtiles_per_e; const LAS int* tb; const LAS int* tokt;
    __device__ __forceinline__ bool next(int i, Unit& u) const {
        if constexpr (!GATH) {
            const int nF = tb[104] * NT, nL = tb[144] * NT; int L = i * G + c; if (L >= nF + nL) return false;
            const int lite = L >= nF ? 1 : 0, n = lite ? nL : nF; if (lite) L -= nF;
            { const int q = n / 8, r = n % 8, xcd = L % 8, off = L / 8; L = (xcd < r ? xcd * (q + 1) : r * (q + 1) + (xcd - r) * q) + off; }
            const LAS int* P = tb + (lite ? 112 : 72);
            int e = 0;
            for (int k = 1; k < 32; ++k) if (L >= P[k] * NT) e = k;
            const int q = L - P[e] * NT, fe = tb[72 + e + 1] - tb[72 + e];
            if (lite) { u.aux = fe; u.pn = q; } else { u.aux = q % fe; u.pn = q / fe; }
            u.pm = (tb[32 + e] >> 8) + u.aux; u.kind = e; u.slot = i; u.lite = lite; return true;
        }
        const int total = (tb[64] >> 8) * NT; int L = i * G + c; if (L >= total) return false;
        { const int q = total / 8, r = total % 8, xcd = L % 8, off = L / 8; L = (xcd < r ? xcd * (q + 1) : r * (q + 1) + (xcd - r) * q) + off; }
        int e = 0;
        for (int k = 1; k < 32; ++k) if (L >= (tb[32 + k] >> 8) * NT) e = k;
        const int mt = (tb[32 + e + 1] - tb[32 + e]) >> 8, q = L - (tb[32 + e] >> 8) * NT;
        u.aux = q % mt; u.pm = (tb[32 + e] >> 8) + u.aux; u.pn = q / mt; u.kind = e; u.slot = i; u.lite = (tb[e] - u.aux * 256 <= 128) ? 1 : 0; return true;
    }
    __device__ __forceinline__ void ptrs(const Unit& u, unsigned& a, unsigned& b) const { a = GATH ? offA : offA + (unsigned)u.pm * tsA; b = offW + (unsigned)(u.kind * wtiles_per_e + u.pn) * tsW; }
    __device__ __forceinline__ int arow(int slot, int row) const { return GATH ? tokt[slot * 256 + row] : 0; }
};
__device__ __forceinline__ void fill_unit_tokens(Frame& F, const SchedExpert<true>& S) {
    LAS int* tokt = (LAS int*)(F.lds + TOKT_OFF); const LAS int* tb = (const LAS int*)(F.lds + MISC_OFF); const unsigned* LISTTOK = wsp<unsigned>(F, WS_LISTTOK);
    Unit u;
    for (int i = 0; i < TOKT_UNITS && S.next(i, u); ++i)
        if (F.tid < 256) { const int idx = u.aux * 256 + F.tid; int tok = 0;
            if (idx < tb[u.kind]) { const int pos = list_pos((const LAS int*)(F.lds + PRE_OFF) + 512, u.kind, idx); const unsigned ent = LISTTOK[pos]; tok = (int)(ent & 0xffffu);
                if (u.pn == 0) { wsp<unsigned>(F, WS_DLT)[u.kind * 8192 + idx] = ent; wsp<float>(F, WS_DLW)[u.kind * 8192 + idx] = wsp<float>(F, WS_LISTW)[pos]; } }
            tokt[i * 256 + F.tid] = tok; }
    __syncthreads();
}
struct EpiExp1 {
    unsigned char* ws; const LAS int* tokt;
    __device__ __forceinline__ void operator()(AccRef acc, const Unit& u, int wr, int wc, int fr, int fq) const {
        asm volatile("" : "+v"(fr), "+v"(fq));
        const float* RSTD = (const float*)(ws + WS_RSTD); unsigned char* ACT = ws + WS_ACT;
#pragma unroll
        for (int ai = 0; ai < 2; ++ai)
#pragma unroll
            for (int m = 0; m < 4; ++m) { if (ai == 1 && u.lite) continue;
                const int rl = ai * 128 + wr * 64 + m * 16 + fr; const float rs = RSTD[tokt[u.slot * 256 + rl]] * (1.0f / 64.0f);
                f32x4 o[2];
#pragma unroll
                for (int n = 0; n < 2; ++n)
#pragma unroll
                    for (int j = 0; j < 4; ++j) o[n][j] = siluf_(acc[ai][0][m][n][j] * rs) * (acc[ai][1][m][n][j] * rs);
                u32x2 o8; o8.x = pk4_fp8(o[0].x, o[0].y, o[0].z, o[0].w); o8.y = pk4_fp8(o[1].x, o[1].y, o[1].z, o[1].w);
                *(GAS u32x2*)(ACT + (size_t)(u.pm * 256 + rl) * 512 + u.pn * 128 + wc * 32 + 8 * fq) = o8; }
    }
};
struct EpiExp2 {
    unsigned char* ws; const LAS int* tb;
    __device__ __forceinline__ void operator()(AccRef acc, const Unit& u, int wr, int wc, int fr, int fq) const {
        asm volatile("" : "+v"(fr), "+v"(fq));
        const unsigned* LISTTOK = (const unsigned*)(ws + WS_DLT); const float* LISTW = (const float*)(ws + WS_DLW); unsigned char* Y = ws + WS_Y;
        const int cnt = tb[u.kind];
#pragma unroll
        for (int ai = 0; ai < 2; ++ai)
#pragma unroll
            for (int m = 0; m < 4; ++m) { const int idx = u.aux * 256 + ai * 128 + wr * 64 + m * 16 + fr;
                if (idx < cnt) { const unsigned ent = LISTTOK[u.kind * 8192 + idx]; const float w = LISTW[u.kind * 8192 + idx] * (16.0f / 32.0f); unsigned char* yp = Y + ((size_t)(ent >> 16) * T + (ent & 0xffffu)) * 2048 + u.pn * 256 + wc * 64 + 16 * fq; u32x4 o8;
#pragma unroll
                    for (int bj = 0; bj < 2; ++bj) { const f32x4 v0 = acc[ai][bj][m][0] * w, v1 = acc[ai][bj][m][1] * w; const unsigned p0 = pk4_fp8(v0.x, v0.y, v0.z, v0.w), p1 = pk4_fp8(v1.x, v1.y, v1.z, v1.w); if (bj) { o8.z = p0; o8.w = p1; } else { o8.x = p0; o8.y = p1; } }
                    *(GAS u32x4*)yp = o8; } }
    }
};
__device__ __forceinline__ void final_phase(Frame& F, const Args& A) {
    const bf16* X1B = wsp<bf16>(F, WS_X1B); const unsigned char* Y = F.ws + WS_Y;
    const int gw = F.bid * 8 + F.wave, NGW = F.G * 8, lane = F.lane;
    f32x4 w[8];
    { const GAS f32x4* wr = (const GAS f32x4*)A.in[I_NORM_FINAL] + lane;
#pragma unroll
      for (int j = 0; j < 8; ++j) w[j] = wr[64 * j]; }
    u32x2 xx[8]; unsigned ya[8], yb[8];
#define FIN_LOAD(m_) do { const GAS u32x2* xr = (const GAS u32x2*)(X1B + (size_t)(m_) * DM) + lane; const GAS unsigned* y0 = (const GAS unsigned*)(Y + (size_t)(m_) * DM) + lane; const GAS unsigned* y1 = (const GAS unsigned*)(Y + ((size_t)T + (m_)) * DM) + lane; \
        _Pragma("unroll") for (int j = 0; j < 8; ++j) { xx[j] = __builtin_nontemporal_load(xr + 64 * j); ya[j] = __builtin_nontemporal_load(y0 + 64 * j); yb[j] = __builtin_nontemporal_load(y1 + 64 * j); } } while (0)
    int m = gw; if (m >= T) return;
    FIN_LOAD(m);
    for (;;) {
        f32x4 v[8]; float s = 0.f;
#pragma unroll
        for (int j = 0; j < 8; ++j) { const f32x4 a = unpk4_fp8(ya[j]), b = unpk4_fp8(yb[j]);
            v[j].x = bf_lo(xx[j].x) + (a.x + b.x) * (1.0f / 16.0f); v[j].y = bf_hi(xx[j].x) + (a.y + b.y) * (1.0f / 16.0f); v[j].z = bf_lo(xx[j].y) + (a.z + b.z) * (1.0f / 16.0f); v[j].w = bf_hi(xx[j].y) + (a.w + b.w) * (1.0f / 16.0f);
            s += (v[j].x * v[j].x + v[j].y * v[j].y) + (v[j].z * v[j].z + v[j].w * v[j].w); }
        const int mn = m + NGW; const bool more = mn < T;
        if (more) FIN_LOAD(mn);
        const float rstd = 1.0f / sqrtf(wave_sum(s) * (1.0f / DM) + RMS_EPS);
        GAS f32x4* o = (GAS f32x4*)(A.out + (size_t)m * DM) + lane;
#pragma unroll
        for (int j = 0; j < 8; ++j) __builtin_nontemporal_store(v[j] * rstd * w[j], o + 64 * j);
        if (!more) break;
        m = mn;
    }
#undef FIN_LOAD
}

constexpr int NPHASE = 10;
__global__ void __launch_bounds__(512, 2) mk_fwd(Args args) {
    extern __shared__ __attribute__((aligned(16))) unsigned char lds_raw[];
    Frame F;
    F.lds = (LAS unsigned char*)lds_raw; F.ldsg = lds_raw; F.ws = args.ws;
    F.tid = threadIdx.x; F.lane = F.tid & 63; F.wave = __builtin_amdgcn_readfirstlane(F.tid >> 6); F.G = gridDim.x; F.bid = blockIdx.x;
    const int lo = args.ph_lo, hi = args.ph_hi;
#define REFRESH() do { F.tid = fresh_tid(); F.lane = F.tid & 63; F.wave = __builtin_amdgcn_readfirstlane(F.tid >> 6); } while (0)
#ifndef MK_PHMASK
#define MK_PHMASK 0x3ff
#endif
#define IN(k) (((MK_PHMASK >> (k)) & 1) && lo <= (k) && (k) < hi)
#if MK_MULTI
#define SEAM(k) do { } while (0)
#else
    { volatile LAS unsigned* mw = (volatile LAS unsigned*)(F.lds + MISC_OFF + 1024); if (F.tid < 16) mw[F.tid] = 0u; __syncthreads(); }
    const XcdBarrier xbar = xcd_barrier_post((unsigned*)(F.ws + WS_CTL) + CW_BAR, (volatile LAS unsigned*)(F.lds + MISC_OFF + 1024));
#define SEAM(k) do { if (IN(k) && IN((k) + 1)) { xcd_barrier(xbar); } } while (0)
#endif
    if (IN(0)) { REFRESH(); p0_prologue(F, args); REFRESH(); p1_tables(F, args, 0); } SEAM(0);
    if (IN(1)) { REFRESH();
        { SchedIn8 S{F.G, F.bid, (const char*)F.ws}; EpiInProj E{F.ws}; pg8::gemm_phase<true, false, true>(F.lds, F.ws, 1024, S, E); }
    } SEAM(1);
    if (IN(2)) { REFRESH(); attn_phase(F); retention_phase(F, args); REFRESH(); filler_convert(F, args, 0, 1 << 30); } SEAM(2);
    if (IN(3)) { REFRESH();
        { SchedDense S{F.G, F.bid, (const char*)F.ws, (unsigned)WS_OA, (unsigned)WS_WMT, 256u * 1024u}; EpiMixA E{F.ws}; pg8::gemm_phase<true, true, false>(F.lds, F.ws, 512, S, E); }
        VM_WAIT(); __syncthreads();
        { SchedDense S{F.G, F.bid, (const char*)F.ws, (unsigned)WS_YR, (unsigned)WS_WRT2, 256u * 2048u}; EpiMixB E{F.ws}; pg8::gemm_phase<true, true, false>(F.lds, F.ws, 1024, S, E); }
    } SEAM(3);
    if (IN(4)) { REFRESH();
        SchedDense S{F.G, F.bid, (const char*)F.ws, (unsigned)WS_MIX, (unsigned)WS_WOT, 256u * 2048u}; EpiOut E{args.in[I_X], F.ws, false};
        pg8::gemm_phase<true, false, true>(F.lds, F.ws, 1024, S, E);
    } SEAM(4);
    if (IN(5)) { REFRESH(); router_phase(F, args); } SEAM(5);
    if (IN(7)) { REFRESH();
        build_tables(F);
        SchedExpert<true> S{F.G, F.bid, 4, (const char*)F.ws, (unsigned)WS_X1B8, (unsigned)WS_W1T, 256u * 2048u, 256u * 2048u, 4, (const LAS int*)(F.lds + MISC_OFF), (const LAS int*)(F.lds + TOKT_OFF)};
        fill_unit_tokens(F, S);
        EpiExp1 E{F.ws, (const LAS int*)(F.lds + TOKT_OFF)};
        pg8::gemm_phase<true, false, false>(F.lds, F.ws, 1024, S, E);
        REFRESH(); filler_convert(F, args, 1, 1 << 30);
    } SEAM(7);
    if (IN(8)) { REFRESH();
        build_tables(F);
        SchedExpert<false> S{F.G, F.bid, 8, (const char*)F.ws, (unsigned)WS_ACT, (unsigned)WS_W2T, 256u * 512u, 256u * 512u, 8, (const LAS int*)(F.lds + MISC_OFF), nullptr};
        EpiExp2 E{F.ws, (const LAS int*)(F.lds + MISC_OFF)};
        pg8::gemm_phase<true, true, false>(F.lds, F.ws, 256, S, E);
    } SEAM(8);
    if (IN(9)) { REFRESH(); final_phase(F, args); }
#undef IN
#undef SEAM
}

extern "C" void kernel_launch(void* const* d_in, const int* in_sizes, int n_in, void* d_out, int out_size, void* d_ws, size_t ws_size, hipStream_t stream) {
    static int grid = 0;
    if (grid == 0) {
        if (n_in != 16 || out_size != T * DM || ws_size < WS_END) { fprintf(stderr, "kernel_launch: unexpected shapes (n_in %d out %d ws %zu)\n", n_in, out_size, ws_size); grid = -1; return; }
        int dev = 0, cus = 0, per_cu = 0;
        (void)hipGetDevice(&dev); (void)hipDeviceGetAttribute(&cus, hipDeviceAttributeMultiprocessorCount, dev);
        (void)hipFuncSetAttribute((const void*)mk_fwd, hipFuncAttributeMaxDynamicSharedMemorySize, LDS_BYTES);
        (void)hipOccupancyMaxActiveBlocksPerMultiprocessor(&per_cu, (const void*)mk_fwd, 512, LDS_BYTES);
        if (per_cu < 1) fprintf(stderr, "kernel_launch: occupancy query says %d blocks/CU\n", per_cu);
        (void)hipGetLastError();
        grid = cus > 0 ? cus : 256;
    }
    if (grid < 0) return;
    (void)hipMemsetAsync((char*)d_ws + WS_CTL, 0, CTL_ZERO_BYTES, stream);
    Args a{};
    for (int i = 0; i < 16; ++i) a.in[i] = (const float*)d_in[i];
    a.out = (float*)d_out; a.ws = (unsigned char*)d_ws;
#if MK_MULTI
    for (int p = 0; p < NPHASE; ++p) { a.ph_lo = p; a.ph_hi = p + 1; hipLaunchKernelGGL(mk_fwd, dim3(grid), dim3(512), LDS_BYTES, stream, a); }
#else
    a.ph_lo = 0; a.ph_hi = NPHASE;
    hipLaunchKernelGGL(mk_fwd, dim3(grid), dim3(512), LDS_BYTES, stream, a);
#endif
}
```

```cpp
#include <hip/hip_runtime.h>
#include <hip/hip_cooperative_groups.h>
#include <cstdio>
#include <cstdint>
namespace cg = cooperative_groups;

#ifndef MK_MULTI
#define MK_MULTI 0
#endif

#define GAS __attribute__((address_space(1)))
#define LAS __attribute__((address_space(3)))
typedef unsigned short bf16;
typedef unsigned u32x4 __attribute__((ext_vector_type(4)));
typedef unsigned u32x2 __attribute__((ext_vector_type(2)));
typedef float f32x4 __attribute__((ext_vector_type(4)));
typedef short bf16x8 __attribute__((ext_vector_type(8)));
typedef float f32x16 __attribute__((ext_vector_type(16)));

constexpr int T = 8192, DM = 2048, SEQ = 4096, NBATCH = 2, NIN = 13312, NHEAD = 8;
constexpr int NEXP = 32, DEXP = 512;
constexpr float RMS_EPS = 1e-6f, GN_EPS = 1e-6f;
constexpr int XG_ROWS = 24576;

constexpr size_t MiB = 1u << 20;
constexpr size_t WS_CTL = 0, CTL_ZERO_BYTES = 1 * MiB;
constexpr size_t OFF_KMEAN = 64 * 1024;
constexpr size_t WS_KMEAN1 = 5 * MiB + 512 * 1024;
constexpr size_t OFF_SSQ = 192 * 1024;
constexpr size_t OFF_CNT = 224 * 1024;
constexpr size_t WS_COS = 1 * MiB, WS_SIN = 2 * MiB;
constexpr size_t WS_WRT = 3 * MiB;
constexpr size_t WS_RSTD = 3 * MiB + 256 * 1024;
constexpr size_t WS_LISTTOK = 3 * MiB + 512 * 1024;
constexpr size_t WS_LISTW = 4 * MiB + 512 * 1024;
constexpr size_t WS_HS = 5 * MiB + 768 * 1024;
constexpr size_t WS_DLT = 6 * MiB, WS_DLW = 7 * MiB;
constexpr size_t WS_ROWTOK = 5 * MiB + 512 * 1024;
constexpr size_t WS_ROWW = WS_ROWTOK + 96 * 1024;
constexpr size_t WS_ROWRS = WS_ROWW + 96 * 1024;
constexpr size_t WS_W1T = 8 * MiB;
constexpr size_t WS_W2T = 136 * MiB;
constexpr size_t WS_WMT = 200 * MiB, WS_WRT2 = 204 * MiB, WS_WOT = 212 * MiB;
constexpr size_t WS_WIN8 = 272 * MiB;
constexpr size_t WS_HB8 = 512 * MiB;
constexpr size_t WS_MQ = 304 * MiB, WS_MK = 320 * MiB, WS_MV = 336 * MiB, WS_RQ = 352 * MiB, WS_RK = 368 * MiB;
constexpr size_t WS_RVT = 384 * MiB;
constexpr size_t WS_RG = 416 * MiB, WS_GA = 448 * MiB, WS_GR = 480 * MiB;
constexpr size_t WS_OA = 220 * MiB;
constexpr size_t WS_YR = 236 * MiB;
constexpr size_t WS_MIXA = 272 * MiB;
constexpr size_t WS_MIX = 304 * MiB;
constexpr size_t WS_X1 = 336 * MiB;
constexpr size_t WS_X1B = 400 * MiB;
constexpr size_t WS_XG = 220 * MiB;
constexpr size_t WS_ACT = 432 * MiB;
constexpr size_t WS_X1B8 = 512 * MiB;
constexpr size_t WS_Y = 220 * MiB;
#ifndef MOBA_KEEP_BF16_QK
#define MOBA_KEEP_BF16_QK 0
#endif
constexpr size_t WS_MQ8 = 464 * MiB, WS_MK8 = 472 * MiB;
constexpr size_t WS_SSQP = 448 * MiB;
constexpr size_t WS_END = 528 * MiB;

constexpr int RING_BYTES = 131072;
constexpr int MISC_OFF = RING_BYTES;
constexpr int LDS_BYTES = 147456;

__device__ __forceinline__ float bf_lo(unsigned u) { return __uint_as_float(u << 16); }
__device__ __forceinline__ float bf_hi(unsigned u) { return __uint_as_float(u & 0xffff0000u); }
__device__ __forceinline__ float bf2f(bf16 b) { return __uint_as_float(((unsigned)b) << 16); }
__device__ __forceinline__ unsigned f2bf(float f) { unsigned u = __float_as_uint(f); return (u + 0x7fffu + ((u >> 16) & 1u)) >> 16; }
typedef float f32x2_t __attribute__((ext_vector_type(2))); typedef __bf16 bf16x2_t __attribute__((ext_vector_type(2)));
__device__ __forceinline__ unsigned pk2(float lo, float hi) { f32x2_t v = {lo, hi}; bf16x2_t b = __builtin_convertvector(v, bf16x2_t); return __builtin_bit_cast(unsigned, b); }
__device__ __forceinline__ unsigned pk4_fp8(float a, float b, float c, float d) { int w = 0; w = __builtin_amdgcn_cvt_pk_fp8_f32(a, b, w, false); w = __builtin_amdgcn_cvt_pk_fp8_f32(c, d, w, true); return (unsigned)w; }
__device__ __forceinline__ f32x4 unpk4_fp8(unsigned w) { typedef float f2_ __attribute__((ext_vector_type(2))); const f2_ lo = __builtin_amdgcn_cvt_pk_f32_fp8((int)w, false), hi = __builtin_amdgcn_cvt_pk_f32_fp8((int)w, true); return (f32x4){lo.x, lo.y, hi.x, hi.y}; }
__device__ __forceinline__ unsigned pk4_i8(float a, float b, float c, float d) {
    const int ia = (int)__builtin_rintf(a), ib = (int)__builtin_rintf(b), ic = (int)__builtin_rintf(c), id = (int)__builtin_rintf(d);
    return ((unsigned)ia & 255u) | (((unsigned)ib & 255u) << 8) | (((unsigned)ic & 255u) << 16) | ((unsigned)id << 24);
}
__device__ __forceinline__ f32x4 i2f4(f32x4 v) { typedef int i4_ __attribute__((ext_vector_type(4))); const i4_ i = __builtin_bit_cast(i4_, v); return (f32x4){(float)i.x, (float)i.y, (float)i.z, (float)i.w}; }
__device__ __forceinline__ u32x4 pack8(f32x4 a, f32x4 b) { u32x4 w; w.x = pk2(a.x, a.y); w.y = pk2(a.z, a.w); w.z = pk2(b.x, b.y); w.w = pk2(b.z, b.w); return w; }
__device__ __forceinline__ float wave_sum(float v) {
#pragma unroll
    for (int o = 1; o < 64; o <<= 1) v += __shfl_xor(v, o);
    return v;
}
__device__ __forceinline__ float wave_max(float v) {
#pragma unroll
    for (int o = 1; o < 64; o <<= 1) v = fmaxf(v, __shfl_xor(v, o));
    return v;
}
__device__ __forceinline__ float sigmoidf_(float v) { return __builtin_amdgcn_rcpf(1.0f + __builtin_amdgcn_exp2f(v * -1.4426950408889634f)); }
__device__ __forceinline__ float siluf_(float v) { return v * __builtin_amdgcn_rcpf(1.0f + __builtin_amdgcn_exp2f(v * -1.4426950408889634f)); }
__device__ __forceinline__ int fresh_tid() { int t = threadIdx.x; asm volatile("" : "+v"(t)); return t; }
#define LDS_WAIT() asm volatile("s_waitcnt lgkmcnt(0)" ::: "memory")
#define VM_WAIT() asm volatile("s_waitcnt vmcnt(0)" ::: "memory")

__device__ __forceinline__ void st16_wt(unsigned char* ws, const void* p, u32x4 v) {
    const __amdgpu_buffer_rsrc_t r = __builtin_amdgcn_make_buffer_rsrc(ws, 0, 0x7ffff000, 0x00020000);
    __builtin_amdgcn_raw_buffer_store_b128(v, r, (int)(unsigned)((const unsigned char*)p - ws), 0, 16);
}
namespace pg8 {
#define PG8_LAS __attribute__((address_space(3)))
typedef unsigned short bf16_t;
constexpr int BM = 256, BK = 64, HALF = 128, HTB = HALF * BK * 2, STAGE_BYTES = 8 * HTB, NXCD = 8, WGM = 8;

__host__ __device__ __forceinline__ int lds_byte(int r, int c) { const int st = (r >> 4) * 2 + (c >> 5), rr = r & 15, cc = c & 31, ob = rr * 64 + cc * 2; return st * 1024 + (ob ^ (((ob >> 9) & 1) << 5)); }
__host__ __device__ __forceinline__ void stage_rc(int b, int& R, int& C) { const int st = b / 1024, sb = b % 1024, swz = sb ^ (((sb >> 9) & 1) << 5); R = (st >> 1) * 16 + swz / 64; C = (st & 1) * 32 + (swz % 64) / 2; }
__host__ __device__ __forceinline__ int perm32(int rho) { const int n = rho >> 4, i = rho & 15; return 8 * (i >> 2) + 4 * n + (i & 3); }

struct Unit { int pm, pn, kind, aux, slot, lite; };

__device__ __forceinline__ void tile_of(int L, int nM, int nN, int& pm, int& pn) {
    const int nwg = nM * nN;
    int wgid = L; { const int q = nwg / NXCD, r = nwg % NXCD, xcd = wgid % NXCD, off = wgid / NXCD; wgid = (xcd < r ? xcd * (q + 1) : r * (q + 1) + (xcd - r) * q) + off; }
    const int nig = WGM * nN, gid = wgid / nig, fm = gid * WGM, gsz = (nM - fm) < WGM ? (nM - fm) : WGM;
    pm = fm + ((wgid % nig) % gsz); pn = (wgid % nig) / gsz;
}

template <bool FP8, bool CP, bool I8, class Epi, class Sched>
__device__ __forceinline__ void gemm_phase(PG8_LAS unsigned char* lds, unsigned char* wsbase, const int K, const Sched& S, const Epi& E) {
    const __amdgpu_buffer_rsrc_t rsrc = __builtin_amdgcn_make_buffer_rsrc(wsbase, 0, 0x7ffff000, 0x00020000);
    const int tid = fresh_tid(), wid = __builtin_amdgcn_readfirstlane(tid >> 6), lane = tid & 63, wr = wid >> 2, wc = wid & 3, fr = lane & 15, fq = lane >> 4;
    const int nt = K / BK;
    unsigned voffA[2], voffB[2];
    int gR[2]; unsigned gC[2];
#pragma unroll
    for (int i = 0; i < 2; ++i) { int R, C; stage_rc(tid * 16 + i * 8192, R, C); const int Rb = ((R & ~31) + perm32(R & 31));
        const int l5 = perm32(R & 31), Rc = CP ? 64 * (R >> 5) + 16 * (l5 >> 3) + (l5 & 7) : Rb;
        voffA[i] = (unsigned)(R * K + C) * 2u; voffB[i] = (unsigned)(Rc * K + C) * 2u; gR[i] = R; gC[i] = (unsigned)C * 2u; }
    const unsigned kstep = (unsigned)(BK * 2);
    const unsigned hstep = (unsigned)(HALF * K * 2);
    const unsigned hstepB = CP ? (unsigned)(8 * K * 2) : hstep;
    unsigned ldsw = (unsigned)wid * 1024u;
    const int aoff = lds_byte(wr * 64 + fr, fq * 8), boff = lds_byte(wc * 32 + fr, fq * 8);
#define PG8_SA(b, h) (((b) * 2 + (h)) * HTB)
#define PG8_SB(b, h) ((4 + (b) * 2 + (h)) * HTB)
#define PG8_STAGE(bufoff, gbase, voff) do { _Pragma("unroll") for (int _i = 0; _i < 2; ++_i) \
        __builtin_amdgcn_raw_ptr_buffer_load_lds(rsrc, (PG8_LAS unsigned*)(lds + (bufoff) + ldsw + _i * 8192), 16, (int)(voff)[_i], (int)(gbase), 0, 0); } while (0)
#define PG8_STAGE_A(bufoff, gbase, half, isnext) do { if constexpr (Sched::GATHER) { unsigned vo_[2]; const int sl_ = (isnext) ? nslot : cur.slot; \
            _Pragma("unroll") for (int i_ = 0; i_ < 2; ++i_) vo_[i_] = (unsigned)S.arow(sl_, gR[i_] + 128 * (half)) * (unsigned)(2 * K) + gC[i_]; PG8_STAGE(bufoff, gbase, vo_); } \
        else PG8_STAGE(bufoff, (gbase) + (half) * hstep, voffA); } while (0)
#define PG8_LDA(dst, b, h) do { if constexpr (FP8) { _Pragma("unroll") for (int m = 0; m < 4; ++m) dst##8[m] = __builtin_shufflevector(*(const PG8_LAS i32x4_*)(lds + PG8_SA(b, h) + aoff + m * 2048), *(const PG8_LAS i32x4_*)(lds + PG8_SA(b, h) + aoff + m * 2048 + 1024), 0, 1, 2, 3, 4, 5, 6, 7); } \
        else { _Pragma("unroll") for (int m = 0; m < 4; ++m) _Pragma("unroll") for (int k = 0; k < 2; ++k) dst[m][k] = *(const PG8_LAS bf16x8*)(lds + PG8_SA(b, h) + aoff + m * 2048 + k * 1024); } } while (0)
#define PG8_LDB(dst, b, h) do { if constexpr (FP8) { _Pragma("unroll") for (int n = 0; n < 2; ++n) dst##8[n] = __builtin_shufflevector(*(const PG8_LAS i32x4_*)(lds + PG8_SB(b, h) + boff + n * 2048), *(const PG8_LAS i32x4_*)(lds + PG8_SB(b, h) + boff + n * 2048 + 1024), 0, 1, 2, 3, 4, 5, 6, 7); } \
        else { _Pragma("unroll") for (int n = 0; n < 2; ++n) _Pragma("unroll") for (int k = 0; k < 2; ++k) dst[n][k] = *(const PG8_LAS bf16x8*)(lds + PG8_SB(b, h) + boff + n * 2048 + k * 1024); } } while (0)
#define PG8_MMA(ai, bj, At, Bt) do { __builtin_amdgcn_s_setprio(1); _Pragma("unroll") for (int m = 0; m < 4; ++m) _Pragma("unroll") for (int n = 0; n < 2; ++n) { \
        if constexpr (FP8)   \
            { if constexpr (I8) {   \
                i32x4_ c_ = __builtin_bit_cast(i32x4_, acc[ai][bj][m][n]); \
                c_ = __builtin_amdgcn_mfma_i32_16x16x64_i8(__builtin_shufflevector(Bt##8[n], Bt##8[n], 0, 1, 2, 3), __builtin_shufflevector(At##8[m], At##8[m], 0, 1, 2, 3), c_, 0, 0, 0); \
                c_ = __builtin_amdgcn_mfma_i32_16x16x64_i8(__builtin_shufflevector(Bt##8[n], Bt##8[n], 4, 5, 6, 7), __builtin_shufflevector(At##8[m], At##8[m], 4, 5, 6, 7), c_, 0, 0, 0); \
                acc[ai][bj][m][n] = __builtin_bit_cast(f32x4, c_); } \
              else acc[ai][bj][m][n] = __builtin_amdgcn_mfma_scale_f32_16x16x128_f8f6f4(Bt##8[n], At##8[m], acc[ai][bj][m][n], 0, 0, 0, 0x7F7F7F7F, 0, 0x7F7F7F7F); } \
        else { _Pragma("unroll") for (int k = 0; k < 2; ++k) acc[ai][bj][m][n] = __builtin_amdgcn_mfma_f32_16x16x32_bf16(Bt[n][k], At[m][k], acc[ai][bj][m][n], 0, 0, 0); } } \
        __builtin_amdgcn_s_setprio(0); } while (0)
#define PG8_WAIT_V(n) asm volatile("s_waitcnt vmcnt(" #n ")" ::: "memory")
#define PG8_WAIT_L(n) asm volatile("s_waitcnt lgkmcnt(" #n ")" ::: "memory")
#define PG8_BAR __builtin_amdgcn_s_barrier()
#define PG8_SCHED __builtin_amdgcn_sched_barrier(0)
    Unit cur, nxt; int ui = 0;
    if (!S.next(0, cur)) return;
    f32x4 acc[2][2][4][2];
#pragma unroll
    for (int a = 0; a < 2; ++a)
#pragma unroll
        for (int b = 0; b < 2; ++b)
#pragma unroll
            for (int m = 0; m < 4; ++m)
#pragma unroll
                for (int n = 0; n < 2; ++n) acc[a][b][m][n] = (f32x4){0.f, 0.f, 0.f, 0.f};
    typedef int i32x4_ __attribute__((ext_vector_type(4))); typedef int i32x8_ __attribute__((ext_vector_type(8)));
    bf16x8 At[4][2], B0[2][2], B1[2][2]; i32x8_ At8[4], B08[2], B18[2];
    unsigned cA, cB; S.ptrs(cur, cA, cB);
    int nslot = cur.slot;
    bool lite = false; if constexpr (Sched::LITE) lite = cur.lite != 0;
    PG8_STAGE(PG8_SB(0, 0), cB, voffB); PG8_STAGE(PG8_SB(0, 1), cB + hstepB, voffB); PG8_STAGE_A(PG8_SA(0, 0), cA, 0, false); PG8_STAGE_A(PG8_SA(0, 1), cA, 1, false);
    if (wr == 1) PG8_BAR;
    PG8_WAIT_V(2); PG8_BAR;
    PG8_STAGE(PG8_SB(1, 0), cB + kstep, voffB); PG8_STAGE_A(PG8_SA(1, 0), cA + kstep, 0, false); PG8_STAGE(PG8_SB(1, 1), cB + hstepB + kstep, voffB);
    PG8_WAIT_V(6); PG8_BAR;
    for (;;) {
        const bool has_next = S.next(ui + 1, nxt);
        unsigned nA = cA, nB = cB; if (has_next) S.ptrs(nxt, nA, nB);
        nslot = has_next ? nxt.slot : cur.slot;
#define PG8_ON(...) __VA_ARGS__
#define PG8_OFF(...)
#define PG8_KLOOP(H1) _Pragma("unroll 1") \
        for (int t = 0; t < nt; t += 2) { \
            asm volatile("" : "+s"(ldsw));                                     \
            const bool last = (t == nt - 2); \
            const unsigned a1 = cA + (unsigned)(t + 1) * kstep; \
            const unsigned a2 = last ? nA : cA + (unsigned)(t + 2) * kstep, b2 = last ? nB : cB + (unsigned)(t + 2) * kstep; \
            const unsigned a3 = a2 + kstep, b3 = b2 + kstep; \
            PG8_LDB(B0, 0, 0); PG8_LDB(B1, 0, 1); PG8_SCHED; PG8_LDA(At, 0, 0); PG8_STAGE_A(PG8_SA(1, 1), a1, 1, false); \
            PG8_WAIT_V(8); PG8_WAIT_L(0); PG8_BAR; PG8_MMA(0, 0, At, B0); PG8_MMA(0, 1, At, B1); PG8_BAR; PG8_SCHED; \
            H1(PG8_LDA(At, 0, 1);) PG8_STAGE(PG8_SB(0, 0), b2, voffB); PG8_STAGE(PG8_SB(0, 1), b2 + hstepB, voffB); PG8_STAGE_A(PG8_SA(0, 0), a2, 0, last); \
            PG8_WAIT_V(8); PG8_WAIT_L(0); PG8_BAR; H1(PG8_MMA(1, 0, At, B0); PG8_MMA(1, 1, At, B1);) PG8_BAR; PG8_SCHED; \
            PG8_LDB(B0, 1, 0); PG8_LDB(B1, 1, 1); PG8_SCHED; PG8_LDA(At, 1, 0); PG8_STAGE_A(PG8_SA(0, 1), a2, 1, last); \
            PG8_WAIT_V(8); PG8_WAIT_L(0); PG8_BAR; PG8_MMA(0, 0, At, B0); PG8_MMA(0, 1, At, B1); PG8_BAR; PG8_SCHED; \
            H1(PG8_LDA(At, 1, 1);) PG8_STAGE(PG8_SB(1, 0), b3, voffB); PG8_STAGE(PG8_SB(1, 1), b3 + hstepB, voffB); PG8_STAGE_A(PG8_SA(1, 0), a3, 0, last); \
            PG8_WAIT_V(8); PG8_WAIT_L(0); PG8_BAR; H1(PG8_MMA(1, 0, At, B0); PG8_MMA(1, 1, At, B1);) PG8_BAR; PG8_SCHED; \
        }
        if (Sched::LITE && lite) { PG8_KLOOP(PG8_OFF) } else { PG8_KLOOP(PG8_ON) }
#undef PG8_KLOOP
#undef PG8_ON
#undef PG8_OFF
        if (wr == 0) PG8_BAR;
        if constexpr (I8) {
#pragma unroll
            for (int a = 0; a < 2; ++a)
#pragma unroll
                for (int b = 0; b < 2; ++b)
#pragma unroll
                    for (int m = 0; m < 4; ++m)
#pragma unroll
                        for (int n = 0; n < 2; ++n) acc[a][b][m][n] = i2f4(acc[a][b][m][n]);
        }
        E(acc, cur, wr, wc, fr, fq);
        if (!has_next) break;
#pragma unroll
        for (int a = 0; a < 2; ++a)
#pragma unroll
            for (int b = 0; b < 2; ++b)
#pragma unroll
                for (int m = 0; m < 4; ++m)
#pragma unroll
                    for (int n = 0; n < 2; ++n) acc[a][b][m][n] = (f32x4){0.f, 0.f, 0.f, 0.f};
        cur = nxt; cA = nA; cB = nB; ++ui;
        if constexpr (Sched::LITE) lite = cur.lite != 0;
        if (wr == 1) PG8_BAR;
    }
    PG8_WAIT_V(0);
    PG8_BAR;
#undef PG8_SA
#undef PG8_SB
#undef PG8_STAGE
#undef PG8_STAGE_A
#undef PG8_LDA
#undef PG8_LDB
#undef PG8_MMA
#undef PG8_WAIT_V
#undef PG8_WAIT_L
#undef PG8_BAR
#undef PG8_SCHED
}
}
using pg8::Unit;
typedef const f32x4 (&AccRef)[2][2][4][2];

struct Args { const float* in[16]; float* out; unsigned char* ws; int ph_lo, ph_hi; };

struct Frame {
    LAS unsigned char* lds; unsigned char* ldsg;
    unsigned char* ws;
    int tid, lane, wave, G, bid;
};
template <class Tp> __device__ __forceinline__ Tp* wsp(const Frame& F, size_t off) { return (Tp*)(F.ws + off); }
enum { I_X = 0, I_NORM_MIX = 1, I_W_IN = 2, I_GN_W = 3, I_W_BM = 4, I_W_BR = 5, I_W_OUT = 6, I_NORM_FFN = 7, I_W_RG = 8, I_B_RG = 9, I_W_RE = 10, I_B_RE = 11, I_W_EG = 12, I_W_EU = 13, I_W_ED = 14, I_NORM_FINAL = 15 };


constexpr int CW_BAR = 4096;
#define XB_TMO      128
#define XB_XCNT(j)  (256  + 64 * (j))
#define XB_XSUB(j)  (1280 + 64 * (j))
#define XB_XGEN(j)  (2304 + 64 * (j))
#define XB_TOP      3328
#define XB_TOPGEN   3392
#define XCD_BAR_WORDS 3456
#define XB_SPIN_CAP (1u << 22)
__device__ __forceinline__ unsigned xb_ld(unsigned* p)              { return __hip_atomic_load(p, __ATOMIC_RELAXED, __HIP_MEMORY_SCOPE_AGENT); }
__device__ __forceinline__ unsigned xb_add(unsigned* p, unsigned v) { return __hip_atomic_fetch_add(p, v, __ATOMIC_RELAXED, __HIP_MEMORY_SCOPE_AGENT); }
__device__ __forceinline__ unsigned xb_xcc_id() { return (unsigned)__builtin_amdgcn_s_getreg((3 << 11) | 20) & 0xFu; }
#define XB_SPIN(cond, bar) do { unsigned _sp = 0; while (cond) { __builtin_amdgcn_s_sleep(1); \
    if ((++_sp & 255u) == 0u) { if (xb_ld(&(bar)[XB_TMO])) break; if (_sp > XB_SPIN_CAP) { atomicAdd(&(bar)[XB_TMO], 1u); break; } } } } while (0)
struct XcdBarrier { unsigned* bar; unsigned x; volatile LAS unsigned* st; };
__device__ __forceinline__ XcdBarrier xcd_barrier_post(unsigned* bar, volatile LAS unsigned* st) {
    XcdBarrier b; b.bar = bar; b.x = xb_xcc_id(); b.st = st;
    if (threadIdx.x == 0) (void)xb_add(&bar[XB_XCNT(b.x)], 1u);
    return b;
}
__device__ __forceinline__ void xcd_barrier_complete(unsigned* bar, unsigned x, unsigned& nloc, unsigned& nx) {
    const unsigned G = gridDim.x * gridDim.y * gridDim.z;
    unsigned sum, cnt, mine, sp = 0u;
    for (;;) {
        sum = 0u; cnt = 0u; mine = 0u;
#pragma unroll
        for (unsigned j = 0; j < 16; ++j) { const unsigned c = xb_ld(&bar[XB_XCNT(j)]); sum += c; cnt += (c > 0u) ? 1u : 0u; mine = (j == x) ? c : mine; }
        if (sum == G) break;
        __builtin_amdgcn_s_sleep(1);
        if ((++sp & 255u) == 0u) { if (xb_ld(&bar[XB_TMO])) break; if (sp > XB_SPIN_CAP) { atomicAdd(&bar[XB_TMO], 1u); break; } }
    }
    nloc = mine > 0u ? mine : 1u; nx = cnt > 0u ? cnt : 1u;
}
__device__ __forceinline__ void xcd_barrier(const XcdBarrier& b) {
    asm volatile("s_waitcnt vmcnt(0)" ::: "memory");
    __syncthreads();
    if (threadIdx.x == 0) {
        unsigned* bar = b.bar;
        __builtin_amdgcn_s_waitcnt(0);
        unsigned nloc = b.st[0], nx = b.st[1];
        if (nloc == 0u) { xcd_barrier_complete(bar, b.x, nloc, nx); b.st[0] = nloc; b.st[1] = nx; }
        const unsigned old = xb_add(&bar[XB_XSUB(b.x)], 1u);
        const unsigned gen = old / nloc;
        if (old + 1u == (gen + 1u) * nloc) {
            __builtin_amdgcn_fence(__ATOMIC_RELEASE, "agent");
            asm volatile("s_waitcnt vmcnt(0)" ::: "memory");
            const unsigned og = xb_add(&bar[XB_TOP], 1u);
            const unsigned tg = og / nx;
            if (og + 1u == (tg + 1u) * nx) xb_add(&bar[XB_TOPGEN], 1u);
            else XB_SPIN(xb_ld(&bar[XB_TOPGEN]) == tg, bar);
            __builtin_amdgcn_fence(__ATOMIC_ACQUIRE, "agent");
            xb_add(&bar[XB_XGEN(b.x)], 1u);
            asm volatile("s_waitcnt vmcnt(0)" ::: "memory");
        } else {
            XB_SPIN(xb_ld(&bar[XB_XGEN(b.x)]) == gen, bar);
            __builtin_amdgcn_fence(__ATOMIC_ACQUIRE, "agent");
            asm volatile("s_waitcnt vmcnt(0)" ::: "memory");
        }
    }
    __syncthreads();
}

constexpr float W_IN_SCALE = 1365.0f;
struct TItem { const float* src; const float* ksc; bf16* dst; int N, K; float fp8; int kso; };
__device__ __forceinline__ int win_drow(int n0, int& fp8) {
    fp8 = 1;
    if (n0 < 3072) return n0;
    if (n0 < 5120) { const int t0 = (n0 - 3072) & ~255, c = n0 & 255, hl = c >> 7, d = c & 127, half = d >> 6, i = d & 63; return 9216 + t0 + half * 128 + hl * 64 + i; }
    if (n0 < 7168) return n0 - 5120 + 11264;
    return n0 - 7168 + 3072;
}
constexpr int TI_IN8 = 16 * 416, TI_IN = TI_IN8, TI_WM = 8 * 64, TI_WR = 16 * 64, TI_WO = 16 * 64, TI_E = 32 * 256;
constexpr int TI_DENSE = TI_IN + TI_WM + TI_WR + TI_WO, TI_ALL = TI_DENSE + 3 * TI_E;
__device__ __forceinline__ TItem titem_decode(const Frame& F, const Args& A, int it, int lane) {
    const float* W; const float* ksc = nullptr; bf16* WT; int K, N, k0, n0, drow0, fp8 = 0; unsigned char* W8 = F.ws + WS_WIN8; float s8 = 64.f;
    int r = it;
    if (r < TI_IN) { const int kb = r / 416, nb = r % 416; W = A.in[I_W_IN]; K = 2048; N = NIN; WT = nullptr; n0 = nb * 32; drow0 = win_drow(n0, fp8); k0 = kb * 128; s8 = -W_IN_SCALE; }
    else if ((r -= TI_IN) < TI_WM) { const int kb = r / 64, nb = r % 64; W = A.in[I_W_BM]; K = 1024; N = 2048; WT = nullptr; fp8 = 1; W8 = F.ws + WS_WMT; s8 = 32.f; k0 = kb * 128; n0 = nb * 32; drow0 = n0; }
    else if ((r -= TI_WM) < TI_WR) { const int kb = r / 64, nb = r % 64; W = A.in[I_W_BR]; K = 2048; N = 2048; WT = nullptr; fp8 = 1; W8 = F.ws + WS_WRT2; s8 = 32.f; k0 = kb * 128; n0 = nb * 32; drow0 = n0; }
    else if ((r -= TI_WR) < TI_WO) { const int kb = r / 64, nb = r % 64; W = A.in[I_W_OUT]; K = 2048; N = 2048; WT = nullptr; fp8 = 1; W8 = F.ws + WS_WOT; s8 = -W_IN_SCALE; k0 = kb * 128; n0 = nb * 32; drow0 = n0; }
    else if ((r -= TI_WO) < 2 * TI_E) { const int up = r >= TI_E; if (up) r -= TI_E; const int e = r >> 8, q = r & 255, kb = q >> 4, nb = q & 15;
        W = (up ? A.in[I_W_EU] : A.in[I_W_EG]) + (size_t)e * 2048 * 512; ksc = A.in[I_NORM_FFN]; K = 2048; N = 512; WT = nullptr; fp8 = 1; W8 = F.ws + WS_W1T; s8 = 64.f; k0 = kb * 128; n0 = nb * 32; drow0 = e * 1024 + (n0 >> 7) * 256 + up * 128 + (n0 & 127); }
    else { r -= 2 * TI_E; const int e = r >> 8, q = r & 255, kb = q >> 6, nb = q & 63; W = A.in[I_W_ED] + (size_t)e * 512 * 2048; K = 512; N = 2048; WT = nullptr; fp8 = 1; W8 = F.ws + WS_W2T; s8 = 32.f; k0 = kb * 128; n0 = nb * 32; drow0 = e * 2048 + n0; }
    const int c = lane & 7, g = (lane >> 3) * (fp8 ? 16 : 8);
    TItem t; t.src = W + (size_t)(k0 + g) * N + n0 + 4 * c; t.ksc = ksc ? ksc + k0 + g : nullptr; t.kso = k0 + g; t.N = N; t.K = K; t.fp8 = fp8 ? s8 : 0.f;
    if (fp8) t.dst = (bf16*)(W8 + (size_t)(drow0 + 4 * c) * K + k0 + g); else t.dst = WT + (size_t)(drow0 + 4 * c) * K + k0 + g;
    return t;
}
__device__ __forceinline__ void titem_load(const TItem& t, f32x4 (&v)[16]) {
#pragma unroll
    for (int i = 0; i < 8; ++i) v[i] = __builtin_nontemporal_load((const GAS f32x4*)(t.src + (size_t)i * t.N));
    if (t.fp8 != 0.f) {
#pragma unroll
        for (int i = 8; i < 16; ++i) v[i] = __builtin_nontemporal_load((const GAS f32x4*)(t.src + (size_t)i * t.N)); }
}
__device__ __forceinline__ void titem_store(const TItem& t, f32x4 (&v)[16], unsigned char* ws, const LAS float* kl) {
    if (t.fp8 != 0.f) {
        if (t.ksc) {
#pragma unroll
            for (int q = 0; q < 4; ++q) { const f32x4 sq = *(const LAS f32x4*)(kl + t.kso + 4 * q); v[4 * q] *= sq.x; v[4 * q + 1] *= sq.y; v[4 * q + 2] *= sq.z; v[4 * q + 3] *= sq.w; } }
        if (t.fp8 < 0.f) { const float s = -t.fp8;
#define I8C(x_) __builtin_amdgcn_fmed3f((x_) * s, -127.0f, 127.0f)
#pragma unroll
            for (int j = 0; j < 4; ++j) { u32x4 o; o.x = pk4_i8(I8C(v[0][j]), I8C(v[1][j]), I8C(v[2][j]), I8C(v[3][j])); o.y = pk4_i8(I8C(v[4][j]), I8C(v[5][j]), I8C(v[6][j]), I8C(v[7][j]));
                o.z = pk4_i8(I8C(v[8][j]), I8C(v[9][j]), I8C(v[10][j]), I8C(v[11][j])); o.w = pk4_i8(I8C(v[12][j]), I8C(v[13][j]), I8C(v[14][j]), I8C(v[15][j]));
                st16_wt(ws, (unsigned char*)t.dst + (size_t)j * t.K, o); }
#undef I8C
            return; }
        const float s = t.fp8;
#pragma unroll
        for (int j = 0; j < 4; ++j) { u32x4 o; o.x = pk4_fp8(v[0][j] * s, v[1][j] * s, v[2][j] * s, v[3][j] * s); o.y = pk4_fp8(v[4][j] * s, v[5][j] * s, v[6][j] * s, v[7][j] * s);
            o.z = pk4_fp8(v[8][j] * s, v[9][j] * s, v[10][j] * s, v[11][j] * s); o.w = pk4_fp8(v[12][j] * s, v[13][j] * s, v[14][j] * s, v[15][j] * s);
            st16_wt(ws, (unsigned char*)t.dst + (size_t)j * t.K, o); }
        return; }
#pragma unroll
    for (int j = 0; j < 4; ++j) { u32x4 o; o.x = pk2(v[0][j], v[1][j]); o.y = pk2(v[2][j], v[3][j]); o.z = pk2(v[4][j], v[5][j]); o.w = pk2(v[6][j], v[7][j]);
        st16_wt(ws, t.dst + (size_t)j * t.K, o); }
}
__device__ __forceinline__ void transpose_items(Frame& F, const Args& A, int first, int last, int start, int NGW) {
    const int lane = F.lane;
    int it = first + start; if (it >= last) return;
    TItem ta = titem_decode(F, A, it, lane), tb = ta, tc = ta; f32x4 a[16], b[16], c[16];
    titem_load(ta, a);
    bool hb = it + NGW < last, hc = false;
    if (hb) { tb = titem_decode(F, A, it + NGW, lane); titem_load(tb, b); }
    for (;;) {
        hc = it + 2 * NGW < last; if (hc) { tc = titem_decode(F, A, it + 2 * NGW, lane); titem_load(tc, c); }
        titem_store(ta, a, F.ws, (const LAS float*)F.lds); if (!hb) break; it += NGW;
        hb = it + 2 * NGW < last; if (hb) { ta = titem_decode(F, A, it + 2 * NGW, lane); titem_load(ta, a); }
        titem_store(tb, b, F.ws, (const LAS float*)F.lds); if (!hc) break; it += NGW;
        hc = it + 2 * NGW < last; if (hc) { tb = titem_decode(F, A, it + 2 * NGW, lane); titem_load(tb, b); }
        titem_store(tc, c, F.ws, (const LAS float*)F.lds); if (!hb) break; it += NGW;
        hb = hc;
    }
}
constexpr size_t OFF_FILL = 228 * 1024;
constexpr int FILL_A_ITEMS = 16;
constexpr int FILL_A_FIRST = TI_IN, FILL_A_CHUNKS = (TI_ALL - TI_E - TI_IN) / FILL_A_ITEMS, FILL_B_FIRST = TI_ALL - TI_E, FILL_B_CHUNKS = TI_E / 32;
static_assert((TI_ALL - TI_E - TI_IN) % FILL_A_ITEMS == 0 && TI_E % 32 == 0, "filler chunks");
__device__ __forceinline__ void filler_convert(Frame& F, const Args& A, int which, int max_chunks) {
    volatile LAS int* slot = (volatile LAS int*)(F.lds + MISC_OFF + 2048);
    unsigned* ctr = (unsigned*)(F.ws + OFF_FILL) + 64 * which;
    const int first = which ? FILL_B_FIRST : FILL_A_FIRST, nch = which ? FILL_B_CHUNKS : FILL_A_CHUNKS, per = which ? 32 : FILL_A_ITEMS;
    if (max_chunks <= 0) return;
    if (which == 0) {
        __syncthreads();
        ((LAS f32x4*)F.lds)[F.tid] = ((const GAS f32x4*)A.in[I_NORM_FFN])[F.tid];
        __syncthreads(); }
    int nxt = 0; if (F.tid == 0) nxt = (int)atomicAdd(ctr, 1u);
    for (int n_ = 0; n_ < max_chunks; ++n_) {
        __syncthreads();
        if (F.tid == 0) *slot = nxt;
        __syncthreads();
        const int ch = *slot;
        if (ch >= nch) break;
        if (F.tid == 0 && n_ + 1 < max_chunks) nxt = (int)atomicAdd(ctr, 1u);
        transpose_items(F, A, first + ch * per, first + ch * per + per, F.wave, 8);
    }
}
__device__ __forceinline__ void p0_prologue(Frame& F, const Args& A) {
    const int gw = F.bid * 8 + F.wave, NGW = F.G * 8, lane = F.lane;
    transpose_items(F, A, 0, TI_IN, gw, NGW);
    f32x4 w[8];
    { const GAS f32x4* wr = (const GAS f32x4*)A.in[I_NORM_MIX] + lane;
#pragma unroll
      for (int j = 0; j < 8; ++j) w[j] = wr[64 * j]; }
    int m = gw; if (m >= T) return;
    f32x4 v[8], nx[8];
    { const GAS f32x4* xr = (const GAS f32x4*)(A.in[I_X] + (size_t)m * DM) + lane;
#pragma unroll
      for (int j = 0; j < 8; ++j) v[j] = xr[64 * j]; }
    for (;;) {
        const int mn = m + NGW; const bool more = mn < T;
        if (more) { const GAS f32x4* xr = (const GAS f32x4*)(A.in[I_X] + (size_t)mn * DM) + lane;
#pragma unroll
            for (int j = 0; j < 8; ++j) nx[j] = xr[64 * j]; }
        float s = 0.f;
#pragma unroll
        for (int j = 0; j < 8; ++j) s += (v[j].x * v[j].x + v[j].y * v[j].y) + (v[j].z * v[j].z + v[j].w * v[j].w);
        const float rstd = 1.0f / sqrtf(wave_sum(s) * (1.0f / DM) + RMS_EPS);
        float am = 0.f;
#pragma unroll
        for (int j = 0; j < 8; ++j) { v[j] = v[j] * rstd * w[j]; am = fmaxf(fmaxf(am, fmaxf(fabsf(v[j].x), fabsf(v[j].y))), fmaxf(fabsf(v[j].z), fabsf(v[j].w))); }
        am = fmaxf(wave_max(am), 1e-20f);
        const float qs = 127.0f / am;
        GAS unsigned* o4 = (GAS unsigned*)(F.ws + WS_HB8 + (size_t)m * DM) + lane;
#pragma unroll
        for (int j = 0; j < 8; ++j) o4[64 * j] = pk4_i8(v[j].x * qs, v[j].y * qs, v[j].z * qs, v[j].w * qs);
        if (lane == 0) wsp<float>(F, WS_HS)[m] = am * (1.0f / 127.0f);
        if (!more) break;
        m = mn;
#pragma unroll
        for (int j = 0; j < 8; ++j) v[j] = nx[j];
    }
}
__device__ __forceinline__ void p1_tables(Frame& F, const Args& A, int first) {
    const int t0 = (F.bid - first) * 512 + F.tid, tstride = (F.G - first) * 512;
    { float* COS = wsp<float>(F, WS_COS); float* SIN = wsp<float>(F, WS_SIN);
      for (int idx = t0; idx < SEQ * 64; idx += tstride) { const int s = idx >> 6, i = idx & 63;
          const float inv = (float)pow(10000.0, -(double)i / 64.0); const float ang = (float)s * inv;
          COS[idx] = (float)cos((double)ang); SIN[idx] = (float)sin((double)ang); } }
    { bf16* WRT = wsp<bf16>(F, WS_WRT);
      for (int idx = t0; idx < 64 * 2048; idx += tstride) { const int j = idx >> 11, k = idx & 2047; float v = 0.f;
          if (j < 4) v = A.in[I_W_RG][k * 4 + j]; else if (j < 36) { const int g = (j - 4) >> 3, e = (j - 4) & 7; v = A.in[I_W_RE][((size_t)g * 2048 + k) * 8 + e]; }
          WRT[idx] = (bf16)f2bf(v * A.in[I_NORM_FFN][k]); } }
}

struct SchedIn8 {
    static constexpr bool GATHER = false, LITE = false;
    int G, c; const char* ws;
    __device__ __forceinline__ bool next(int i, Unit& u) const {
        const int L = i * G + c; if (L >= 1536) return false;
        if (L < 1280) { int pm, jj; pg8::tile_of(L, 32, 40, pm, jj); const int j = jj < 32 ? jj : jj + 4; u.pm = pm; u.pn = j < 12 ? j : (j < 36 ? 16 + j : j - 24); u.kind = 0; u.aux = j; }
        else { const int q = L - 1280; u.pm = q >> 5; u.pn = q & 31; u.kind = 1; u.aux = 44 + u.pm; }
        u.slot = i; return true;
    }
    __device__ __forceinline__ void ptrs(const Unit& u, unsigned& a, unsigned& b) const {
        constexpr unsigned ts = 256u * 2048u, H = (unsigned)WS_HB8, W = (unsigned)WS_WIN8;
        if (u.kind == 0) { a = H + (unsigned)u.pm * ts; b = W + (unsigned)u.aux * ts; } else { a = W + (unsigned)u.aux * ts; b = H + (unsigned)u.pn * ts; }
    }
    __device__ __forceinline__ int arow(int, int) const { return 0; }
};
struct SchedInLate {
    static constexpr bool GATHER = false, LITE = false;
    int NB, c; const char* ws;
    __device__ __forceinline__ bool next(int i, Unit& u) const {
        const int d = i * NB + c; if (d >= 128) return false;
        const int j = 32 + (d & 3); u.pm = d >> 2; u.pn = 16 + j; u.kind = 0; u.aux = j; u.slot = i; return true;
    }
    __device__ __forceinline__ void ptrs(const Unit& u, unsigned& a, unsigned& b) const { constexpr unsigned ts = 256u * 2048u; a = (unsigned)WS_HB8 + (unsigned)u.pm * ts; b = (unsigned)WS_WIN8 + (unsigned)u.aux * ts; }
    __device__ __forceinline__ int arow(int, int) const { return 0; }
};
#ifndef ROT_PF
#define ROT_PF 3
#endif
constexpr int EPI_HSU_OFF = MISC_OFF + 4096;
constexpr int EPI_HS_OFF = MISC_OFF + 14336;
struct EpiInProj {
    unsigned char* ws; LAS unsigned char* lds;
    __device__ __forceinline__ void operator()(AccRef acc, const Unit& u, int wr, int wc, int fr, int fq) const {
        asm volatile("" : "+v"(fr), "+v"(fq));
        bf16* MQ = (bf16*)(ws + WS_MQ); bf16* RQ = (bf16*)(ws + WS_RQ); bf16* RVT = (bf16*)(ws + WS_RVT); bf16* RG = (bf16*)(ws + WS_RG); float* KMEAN = (float*)(ws + (wr ? WS_KMEAN1 : OFF_KMEAN)); const float* COS = (const float*)(ws + WS_COS); const float* SIN = (const float*)(ws + WS_SIN);
        const float* HS = (const float*)(ws + WS_HS);
        if (u.kind == 1) {
            const int b = u.pn >> 4, s0 = (u.pn & 15) * 256 + wc * 32 + 8 * fq;
            bf16* base = RVT + ((size_t)(b * 8 + u.pm) * 256) * 4096 + s0;
            const LAS float* hs = (const LAS float*)(lds + EPI_HSU_OFF + u.slot * 1024) + wc * 32 + 8 * fq;
            f32x4 cs[2][2];
#pragma unroll
            for (int bj = 0; bj < 2; ++bj)
#pragma unroll
                for (int n = 0; n < 2; ++n) cs[bj][n] = *(const LAS f32x4*)(hs + bj * 128 + 4 * n);
#pragma unroll
            for (int ai = 0; ai < 2; ++ai)
#pragma unroll
                for (int m = 0; m < 4; ++m) { const int dv = ai * 128 + wr * 64 + m * 16 + fr;
#pragma unroll
                    for (int bj = 0; bj < 2; ++bj) *(GAS u32x4*)(base + (size_t)dv * 4096 + bj * 128) = pack8(acc[ai][bj][m][0] * cs[bj][0], acc[ai][bj][m][1] * cs[bj][1]); }
            return;
        }
        const int pn = u.pn, b = u.pm >> 4;
#define sb ((u.pm & 15) * 256 + wr * 64 + fr)
#define c8 (wc * 32 + 8 * fq)
        const LAS float* hsl = (const LAS float*)(lds + EPI_HSU_OFF + u.slot * 1024);
#define RS(ai_, m_) hsl[wr * 64 + fr + (ai_) * 128 + (m_) * 16]
        if (pn < 12) {
            asm volatile("" : "+v"(fr), "+v"(fq));
            const int which = pn >> 2; bf16* dst = MQ + (size_t)which * (8u << 20);
#pragma unroll
            for (int bj = 0; bj < 2; ++bj) { const int head = (pn & 3) * 2 + bj; bf16* hb = dst + ((size_t)(b * 8 + head) * 4096) * 128 + c8;
#pragma unroll
                for (int ai = 0; ai < 2; ++ai)
#pragma unroll
                    for (int m = 0; m < 4; ++m) { const f32x4 v0 = acc[ai][bj][m][0] * RS(ai, m), v1 = acc[ai][bj][m][1] * RS(ai, m);
                        if (which == 2 || MOBA_KEEP_BF16_QK) *(GAS u32x4*)(hb + (size_t)(sb + ai * 128 + m * 16) * 128) = pack8(v0, v1);
                        if (which != 2) { u32x2 o8; o8.x = pk4_fp8(v0.x, v0.y, v0.z, v0.w); o8.y = pk4_fp8(v1.x, v1.y, v1.z, v1.w);
                            *(GAS u32x2*)(ws + (which ? WS_MK8 : WS_MQ8) + (((size_t)(b * 8 + head) * 4096) + sb + ai * 128 + m * 16) * 128 + c8) = o8; } } }
            if (which == 1) {
#pragma unroll
                for (int bj = 0; bj < 2; ++bj) { const int head = (pn & 3) * 2 + bj;
#pragma unroll
                    for (int n = 0; n < 2; ++n) { f32x4 s = (f32x4){0.f, 0.f, 0.f, 0.f};
#pragma unroll
                        for (int ai = 0; ai < 2; ++ai)
#pragma unroll
                            for (int m = 0; m < 4; ++m) s += acc[ai][bj][m][n] * RS(ai, m);
#pragma unroll
                        for (int j = 0; j < 4; ++j) { float v = s[j]; v += __shfl_xor(v, 1); v += __shfl_xor(v, 2); v += __shfl_xor(v, 4); v += __shfl_xor(v, 8);
                            if (fr == 0) KMEAN[((size_t)((b * 8 + head) * 16 + (u.pm & 15))) * 128 + c8 + 4 * n + j] = v * (1.0f / 256.0f); } } }
            }
        } else if (pn < 20) {
            asm volatile("" : "+v"(fr), "+v"(fq));
            const bool isk = pn >= 16; const int head = ((pn - 12) & 3) * 2 + (wc >> 1), i0 = (wc & 1) * 32 + 8 * fq;
            bf16* hb = RQ + (isk ? (size_t)(8u << 20) : (size_t)0) + ((size_t)(b * 8 + head) * 4096) * 128 + i0;
            const float nlg = -log2f(1.0f - exp2f(-(5.0f + (float)head)));
            constexpr int PF = ROT_PF; f32x4 rc_[8][2], rn_[8][2];
#define RO_S(st_) (sb + ((st_) >> 2) * 128 + ((st_) & 3) * 16)
#define RO_LD(st_) do { const GAS f32x4* cp_ = (const GAS f32x4*)(COS + (size_t)RO_S(st_) * 64 + i0); const GAS f32x4* sp_ = (const GAS f32x4*)(SIN + (size_t)RO_S(st_) * 64 + i0); \
                rc_[st_][0] = cp_[0]; rc_[st_][1] = cp_[1]; rn_[st_][0] = sp_[0]; rn_[st_][1] = sp_[1]; } while (0)
#pragma unroll
            for (int st = 0; st < PF; ++st) RO_LD(st);
#pragma unroll
            for (int st = 0; st < 8; ++st) { const int ai = st >> 2, m = st & 3; const int s = RO_S(st);
                    if (st + PF < 8) RO_LD(st + PF);
                    __builtin_amdgcn_sched_barrier(0);
                    const float sc = (isk ? 0.08838834764831845f * exp2f((float)((s & 127) + 1) * nlg) : 1.0f) * RS(ai, m);
                    f32x4 o1[2], o2[2];
#pragma unroll
                    for (int n = 0; n < 2; ++n) { const f32x4 c = rc_[st][n], sn = rn_[st][n], x1 = acc[ai][0][m][n], x2 = acc[ai][1][m][n];
                        o1[n] = (x1 * c - x2 * sn) * sc; o2[n] = (x1 * sn + x2 * c) * sc; }
                    *(GAS u32x4*)(hb + (size_t)s * 128) = pack8(o1[0], o1[1]); *(GAS u32x4*)(hb + (size_t)s * 128 + 64) = pack8(o2[0], o2[1]); }
#undef RO_LD
#undef RO_S
        } else {
            asm volatile("" : "+v"(fr), "+v"(fq));
            const int which = pn < 36 ? 0 : (pn < 44 ? 1 : 2); bf16* dst = RG + (size_t)which * (16u << 20);
            const int col0 = (pn - 28 - 8 * which) * 256 + c8;
#pragma unroll
            for (int ai = 0; ai < 2; ++ai)
#pragma unroll
                for (int m = 0; m < 4; ++m) { bf16* rp = dst + (size_t)(u.pm * 256 + wr * 64 + fr + ai * 128 + m * 16) * 2048 + col0;
#pragma unroll
                    for (int bj = 0; bj < 2; ++bj) { f32x4 v0 = acc[ai][bj][m][0] * RS(ai, m), v1 = acc[ai][bj][m][1] * RS(ai, m);
#pragma unroll
                        for (int j = 0; j < 4; ++j) { const float s0 = sigmoidf_(v0[j]), s1 = sigmoidf_(v1[j]); v0[j] = which == 0 ? v0[j] * s0 : s0; v1[j] = which == 0 ? v1[j] * s1 : s1; }
                        if (which == 1) { u32x2 o8; o8.x = pk4_fp8(v0.x, v0.y, v0.z, v0.w); o8.y = pk4_fp8(v1.x, v1.y, v1.z, v1.w);
                            *(GAS u32x2*)((unsigned char*)(ws + WS_GA) + (size_t)(u.pm * 256 + wr * 64 + fr + ai * 128 + m * 16) * 2048 + col0 + bj * 128) = o8; }
                        else *(GAS u32x4*)(rp + bj * 128) = pack8(v0, v1); } }
        }
#undef RS
#undef sb
#undef c8
    }
};
template <class Sched>
__device__ __forceinline__ void stage_in_scales(Frame& F, const Sched& S) {
    const float* HS = (const float*)(F.ws + WS_HS); LAS float* dst = (LAS float*)(F.lds + EPI_HSU_OFF);
    __syncthreads();
    if (F.tid < 256) { float v[6]; bool ok[6];
#pragma unroll
        for (int i = 0; i < 6; ++i) { Unit u; ok[i] = S.next(i, u); v[i] = ok[i] ? HS[(size_t)(u.kind == 1 ? u.pn : u.pm) * 256 + F.tid] : 0.f; }
#pragma unroll
        for (int i = 0; i < 6; ++i) if (ok[i]) dst[i * 256 + F.tid] = v[i] * (1.0f / W_IN_SCALE); }
    __syncthreads();
}
namespace att {
constexpr int D = 128, OSTR = 1024;
constexpr float THR = 8.f;
constexpr bool WSKIP = false;
constexpr float SCALE = 0.08838834764831845f;
constexpr int NW = 8, QBLK = 32, KVBLK = 64, QB = NW * QBLK;
constexpr int SHM_V = KVBLK * D * 2, SHM_K = KVBLK * D * 2;
constexpr int LDS_BYTES = 2 * SHM_V + 2 * SHM_K + NW * 64 * 4;
typedef short bf16x8 __attribute__((ext_vector_type(8)));
typedef short s16x4 __attribute__((ext_vector_type(4)));
typedef float f32x16 __attribute__((ext_vector_type(16)));
typedef float f32x4 __attribute__((ext_vector_type(4)));
__device__ __forceinline__ unsigned moba_select(const bf16x8* qr, const __attribute__((address_space(3))) float* KM, int qb, int hi) {
    if (qb == 0) return 0u;
    const float NEG = -__builtin_inff();
    float v1 = NEG, v2 = NEG, v3 = NEG; int i1 = 0, i2 = 0, i3 = 0;
    __builtin_amdgcn_sched_barrier(0);
#pragma unroll 1
    for (int j = 0; j < qb; ++j) {
        float a = 0.f;
#pragma unroll
        for (int ks = 0; ks < 2; ++ks) { const __attribute__((address_space(3))) f32x4* km = (const __attribute__((address_space(3))) f32x4*)(KM + j * 128 + ks * 64 + hi * 32);
#pragma unroll
            for (int hf = 0; hf < 2; ++hf) { const u32x4 qw = __builtin_bit_cast(u32x4, qr[2 * ks + hf]);
#pragma unroll
                for (int w = 0; w < 4; ++w) { const f32x4 k4 = km[hf * 4 + w]; const f32x4 q4 = unpk4_fp8(qw[w]);
                    a = fmaf(q4.x, k4.x, a); a = fmaf(q4.y, k4.y, a); a = fmaf(q4.z, k4.z, a); a = fmaf(q4.w, k4.w, a); } } }
        a += __shfl_xor(a, 32);
        const bool g1 = a > v1, g2 = a > v2, g3 = a > v3;
        v3 = g2 ? v2 : (g3 ? a : v3); i3 = g2 ? i2 : (g3 ? j : i3);
        v2 = g1 ? v1 : (g2 ? a : v2); i2 = g1 ? i1 : (g2 ? j : i2);
        v1 = g1 ? a : v1; i1 = g1 ? j : i1;
        asm volatile("" : "+v"(v1), "+v"(v2), "+v"(v3));
    }
    unsigned sel = 0u;
    if (v1 > NEG) sel |= 1u << i1;
    if (v2 > NEG) sel |= 1u << i2;
    if (v3 > NEG) sel |= 1u << i3;
    asm volatile("" : "+v"(sel));
    __builtin_amdgcn_sched_barrier(0);
    return sel;
}
typedef unsigned u32x4 __attribute__((ext_vector_type(4)));
template <class A, class Bt> struct same_t { static constexpr bool v = false; };
template <class A> struct same_t<A, A> { static constexpr bool v = true; };

#define KSWZ(row, colB) ((row) * 256 + ((colB) ^ (((row) & 7) << 4)))
#define KSWZ8(row, ch) ((row) * 128 + ((((ch) ^ (((row) >> 1) & 7))) << 4))
#define SBAR() __builtin_amdgcn_sched_barrier(0)
__device__ __forceinline__ int v_st(int k, int c) { const int kk = (k & ~0xC) | ((k & 4) << 1) | ((k & 8) >> 1); return ((kk >> 3) * 4 + (c >> 5)) * 512 + ((kk & 7) * 32 + (c & 31)) * 2; }
__device__ __forceinline__ int v_rd_base(int lane) { return ((lane & 3) << 3) | (((lane >> 2) & 3) << 6) | (((lane >> 4) & 1) << 5) | (((lane >> 5) & 1) << 8); }
constexpr int v_rd_off(int d0, int ks, int half) { return d0 * 512 + ks * 4096 + half * 2048; }
__device__ __forceinline__ int crow(int r, int hi) { return (r & 3) + 8 * (r >> 2) + 4 * hi; }
__device__ __forceinline__ unsigned cvtpk(float lo, float hi) {
    unsigned r; asm volatile("v_cvt_pk_bf16_f32 %0, %1, %2" : "=v"(r) : "v"(lo), "v"(hi)); return r;
}
__device__ __forceinline__ bf16x8 pack8(f32x4 a, f32x4 b) {
    u32x4 w = {cvtpk(a[0], a[1]), cvtpk(a[2], a[3]), cvtpk(b[0], b[1]), cvtpk(b[2], b[3])};
    return *reinterpret_cast<bf16x8*>(&w);
}
template <class T> __device__ __forceinline__ bf16x8 load8(const T* p) {
    if constexpr (same_t<T, float>::v) { return pack8(*(const f32x4*)p, *(const f32x4*)(p + 4)); }
    else { return *reinterpret_cast<const bf16x8*>(p); }
}
__device__ __forceinline__ void mask_tile(f32x16& p0, f32x16& p1, int dq, unsigned W) {
    const float NEG = -__builtin_inff();
#pragma unroll
    for (int r = 0; r < 16; ++r) {
        const int c = (r & 3) + 8 * (r >> 2);
        if ((unsigned)(dq - c) >= W) p0[r] = NEG;
        if ((unsigned)(dq - c - 32) >= W) p1[r] = NEG;
    }
}
__device__ __forceinline__ void partialSM(f32x16& p0, f32x16& p1, float& m_reg, float& mn, float& alpha, bool keep = true) {
    float pmax = p0[0]; for (int r = 1; r < 16; ++r) pmax = fmaxf(pmax, p0[r]); for (int r = 0; r < 16; ++r) pmax = fmaxf(pmax, p1[r]);
    { auto rr = __builtin_amdgcn_permlane32_swap(__float_as_uint(pmax), __float_as_uint(pmax), false, false);
      pmax = fmaxf(__uint_as_float(rr[0]), __uint_as_float(rr[1])); }
    pmax = keep ? pmax : -__builtin_inff();
    constexpr float C2 = 1.4426950408889634f * SCALE;
    if (__builtin_expect(__all((pmax - m_reg) * SCALE <= THR), 1)) { mn = m_reg; alpha = 1.f; }
    else { mn = fmaxf(m_reg, pmax); alpha = __builtin_amdgcn_exp2f((m_reg - mn) * C2); m_reg = mn; }
    const float mnL = keep ? -mn * C2 : -__builtin_inff(), c2 = keep ? C2 : 0.f;
    for (int r = 0; r < 16; ++r) p0[r] = fmaf(p0[r], c2, mnL); for (int r = 0; r < 16; ++r) p1[r] = fmaf(p1[r], c2, mnL);
    for (int r = 0; r < 16; ++r) p0[r] = __builtin_amdgcn_exp2f(p0[r]);
}
__device__ __forceinline__ void finishSM(f32x16& p0, f32x16& p1, float alpha, float& l_reg, bf16x8& pa0, bf16x8& pa1, bf16x8& pa2, bf16x8& pa3) {
    for (int r = 0; r < 16; ++r) p1[r] = __builtin_amdgcn_exp2f(p1[r]);
    float ps = 0; for (int r = 0; r < 16; ++r) ps += p0[r]; for (int r = 0; r < 16; ++r) ps += p1[r];
    { auto rr = __builtin_amdgcn_permlane32_swap(__float_as_uint(ps), __float_as_uint(ps), false, false);
      ps = __uint_as_float(rr[0]) + __uint_as_float(rr[1]); }
    l_reg = l_reg * alpha + ps;
#define PK4(P, B_, OUT) do { unsigned a0 = cvtpk(P[B_+0], P[B_+1]), a1 = cvtpk(P[B_+2], P[B_+3]);                          \
        unsigned b0 = cvtpk(P[B_+4], P[B_+5]), b1 = cvtpk(P[B_+6], P[B_+7]);                                             \
        auto r0 = __builtin_amdgcn_permlane32_swap(a0, b0, false, false); auto r1 = __builtin_amdgcn_permlane32_swap(a1, b1, false, false); \
        u32x4 w = {r0[0], r1[0], r0[1], r1[1]}; OUT = *reinterpret_cast<bf16x8*>(&w); } while (0)
    PK4(p0, 0, pa0); PK4(p0, 8, pa1); PK4(p1, 0, pa2); PK4(p1, 8, pa3);
#undef PK4
}
template <int KB, bool SK>
__device__ __forceinline__ void qkt(f32x16& p0, f32x16& p1, const char* K_lds, int r32, int hi, const bf16x8* qr, bool act) {
    if (SK && !act) { const float NEG = -__builtin_inff();
#pragma unroll
        for (int r = 0; r < 16; ++r) { p0[r] = NEG; p1[r] = NEG; } return; }
    p0 = f32x16{}; p1 = f32x16{};
    typedef int i32x4_ __attribute__((ext_vector_type(4))); typedef int i32x8_ __attribute__((ext_vector_type(8)));
    const char* ra = K_lds + KB * SHM_K;
#pragma unroll
    for (int ks = 0; ks < 2; ++ks) { const int c0 = ks * 4 + hi * 2;
        const i32x8_ b0 = __builtin_shufflevector(*reinterpret_cast<const i32x4_*>(ra + KSWZ8(r32, c0)), *reinterpret_cast<const i32x4_*>(ra + KSWZ8(r32, c0 + 1)), 0, 1, 2, 3, 4, 5, 6, 7);
        const i32x8_ b1 = __builtin_shufflevector(*reinterpret_cast<const i32x4_*>(ra + 32 * 128 + KSWZ8(r32, c0)), *reinterpret_cast<const i32x4_*>(ra + 32 * 128 + KSWZ8(r32, c0 + 1)), 0, 1, 2, 3, 4, 5, 6, 7);
        const i32x8_ q = __builtin_shufflevector(__builtin_bit_cast(i32x4_, qr[2 * ks]), __builtin_bit_cast(i32x4_, qr[2 * ks + 1]), 0, 1, 2, 3, 4, 5, 6, 7);
        p0 = __builtin_amdgcn_mfma_scale_f32_32x32x64_f8f6f4(b0, q, p0, 0, 0, 0, 0x7F7F7F7F, 0, 0x7F7F7F7F);
        p1 = __builtin_amdgcn_mfma_scale_f32_32x32x64_f8f6f4(b1, q, p1, 0, 0, 0, 0x7F7F7F7F, 0, 0x7F7F7F7F); }
}
template <int VB, bool SK>
__device__ __forceinline__ void pv_tile(f32x16* o, int vb0, bf16x8 pa0, bf16x8 pa1, bf16x8 pa2, bf16x8 pa3, bool act) {
    if (SK && !act) return;
#define TRRD(dst, off) asm volatile("ds_read_b64_tr_b16 %0, %1 offset:%2" : "=&v"(dst) : "v"(vb0), "i"(off) : "memory")
#define PV_D0(d0) do { s16x4 l0, l1, l2, l3, h0, h1, h2, h3; constexpr int b_ = VB * SHM_V + v_rd_off(d0, 0, 0);     \
        TRRD(l0, b_); TRRD(h0, b_ + 2048); TRRD(l1, b_ + 4096); TRRD(h1, b_ + 6144); TRRD(l2, b_ + 8192); TRRD(h2, b_ + 10240); TRRD(l3, b_ + 12288); TRRD(h3, b_ + 14336); \
        asm volatile("s_waitcnt lgkmcnt(0)" ::: "memory"); SBAR();                 \
        o[d0] = __builtin_amdgcn_mfma_f32_32x32x16_bf16(pa0, (bf16x8){l0[0], l0[1], l0[2], l0[3], h0[0], h0[1], h0[2], h0[3]}, o[d0], 0, 0, 0);   \
        o[d0] = __builtin_amdgcn_mfma_f32_32x32x16_bf16(pa1, (bf16x8){l1[0], l1[1], l1[2], l1[3], h1[0], h1[1], h1[2], h1[3]}, o[d0], 0, 0, 0);   \
        o[d0] = __builtin_amdgcn_mfma_f32_32x32x16_bf16(pa2, (bf16x8){l2[0], l2[1], l2[2], l2[3], h2[0], h2[1], h2[2], h2[3]}, o[d0], 0, 0, 0);   \
        o[d0] = __builtin_amdgcn_mfma_f32_32x32x16_bf16(pa3, (bf16x8){l3[0], l3[1], l3[2], l3[3], h3[0], h3[1], h3[2], h3[3]}, o[d0], 0, 0, 0); } while (0)
    PV_D0(0); PV_D0(1); PV_D0(2); PV_D0(3);
#undef PV_D0
#undef TRRD
}

template <class TIn, class TOut> struct BlockRef { const TIn* Q; const TIn* K; const TIn* V; TOut* O; int P0; const float* KM; const unsigned char* Q8; const unsigned char* K8; };
template <class TIn> struct Seam {
    bf16x8 qr[8];
    bf16x8 st_v0, st_v1, st_k0, st_k1; f32x4 sf0, sf1, sf2, sf3;
    f32x4 tq[16];
};
__device__ __forceinline__ int swa_jlo(int P0, int W) { const int lowk = P0 - W + 1; return lowk > 0 ? lowk / KVBLK : 0; }
#define ROW(p, k0, rr) ((p) + (size_t)((k0) + (rr)) * D + sc)
#define VMW() asm volatile("s_waitcnt vmcnt(0)" ::: "memory")
#define VMWN(n) asm volatile("s_waitcnt vmcnt(%0)" :: "i"(n) : "memory")
#define SLOAD_H(Kp8, Vp, k0) do { S.st_v0 = load8<TIn>(ROW(Vp, k0, sr)); S.st_v1 = load8<TIn>(ROW(Vp, k0, 32 + sr));              \
                         S.st_k0 = *(const bf16x8*)((Kp8) + (size_t)((k0) + 2 * sr + (sc >> 6)) * 128 + ((sc >> 3) & 7) * 16); } while (0)
#define SWRITE_HK(bf) do { *(bf16x8*)(K_lds + (bf) * SHM_K + kws) = S.st_k0; } while (0)
#define SWRITE_HV(bf) do { *(bf16x8*)(V_lds + (bf) * SHM_V + vst0) = S.st_v0; *(bf16x8*)(V_lds + (bf) * SHM_V + vst1) = S.st_v1; } while (0)
#define SWRITE_H(bf) do { SWRITE_HV(bf); SWRITE_HK(bf); } while (0)
#define SLOAD_F(p, k0) do { S.sf0 = *(const f32x4*)ROW(p, k0, sr); S.sf1 = *(const f32x4*)(ROW(p, k0, sr) + 4);                \
                            S.sf2 = *(const f32x4*)ROW(p, k0, 32 + sr); S.sf3 = *(const f32x4*)(ROW(p, k0, 32 + sr) + 4); } while (0)
#define SWRITE_KF(bf) do { *(bf16x8*)(K_lds + (bf) * SHM_K + kws) = pack8(S.sf0, S.sf1); *(bf16x8*)(K_lds + (bf) * SHM_K + kws + 32 * 256) = pack8(S.sf2, S.sf3); } while (0)
#define SWRITE_VF(bf) do { *(bf16x8*)(V_lds + (bf) * SHM_V + vst0) = pack8(S.sf0, S.sf1); *(bf16x8*)(V_lds + (bf) * SHM_V + vst1) = pack8(S.sf2, S.sf3); } while (0)
template <class TIn, class TOut>
__device__ __forceinline__ void causal_swa_prime(const BlockRef<TIn, TOut>& cur, int W, char* lds, Seam<TIn>& S) {
    constexpr bool F32 = same_t<TIn, float>::v;
    const int tid = fresh_tid(), wid = __builtin_amdgcn_readfirstlane(tid >> 6), lane = tid & 63, r32 = lane & 31, hi = lane >> 5;
    const int sr = tid >> 4, sc = (tid & 15) * 8, kws = KSWZ8(2 * sr + (sc >> 6), (sc >> 3) & 7); char* K_lds = lds + 2 * SHM_V;
    const int kb0 = swa_jlo(cur.P0, W) * KVBLK;
    { const unsigned char* q8 = cur.Q8 + (size_t)(wid * QBLK + r32) * 128 + hi * 32; S.qr[0] = *(const bf16x8*)q8; S.qr[1] = *(const bf16x8*)(q8 + 16); S.qr[2] = *(const bf16x8*)(q8 + 64); S.qr[3] = *(const bf16x8*)(q8 + 80); }
    if constexpr (F32) { SLOAD_F((const float*)cur.K, kb0); VMW(); SWRITE_KF(0); SBAR(); SLOAD_F((const float*)cur.V, kb0); }
    else { SLOAD_H(cur.K8, cur.V, kb0); VMW(); SWRITE_HK(0); }
    __syncthreads();
}
template <class TIn, class TOut>
__device__ __forceinline__ void causal_swa_block(const BlockRef<TIn, TOut>& cur, const BlockRef<TIn, TOut>& nxt, int skv, int W, char* lds, Seam<TIn>& S) {
    constexpr bool F32 = same_t<TIn, float>::v;
    const int tid = fresh_tid(), wid = __builtin_amdgcn_readfirstlane(tid >> 6), lane = tid & 63, r32 = lane & 31, hi = lane >> 5;
    const int j_lo = swa_jlo(cur.P0, W);
    int j_hi = (cur.P0 + QB - 1) / KVBLK + 1; if (j_hi > skv / KVBLK) j_hi = skv / KVBLK;
    const int NT = j_hi - j_lo;
    const int kbn = swa_jlo(nxt.P0, W) * KVBLK;
    const int qlo = cur.P0 + wid * QBLK, qm = qlo + r32 - 4 * hi;
    char* V_lds = lds; char* K_lds = lds + 2 * SHM_V;
    float* ws = (float*)(lds + 2 * SHM_V + 2 * SHM_K) + wid * 64; float* li_l = ws, * al_l = ws + 32;
    { const unsigned sb_ = moba_select(S.qr, (const __attribute__((address_space(3))) float*)(lds + LDS_BYTES + 4096), cur.P0 >> 8, hi); ((unsigned*)(lds + LDS_BYTES))[tid] = sb_; }
    float m_reg = -1e30f, l_reg = 0; f32x16 o[4] = {};
    const int sr = tid >> 4, sc = (tid & 15) * 8, vst0 = v_st(sr, sc), vst1 = v_st(32 + sr, sc), kws = KSWZ8(2 * sr + (sc >> 6), (sc >> 3) & 7);
    const int vb0 = (int)(uintptr_t)V_lds + v_rd_base(lane);
    const unsigned char* Kh = cur.K8; const TIn* Vh = cur.V;
#define RESC(a) do { if (__any((a) < 1.f)) { if (hi == 0) al_l[r32] = (a); asm volatile("s_waitcnt lgkmcnt(0)" ::: "memory");              \
                     for (int d_ = 0; d_ < 4; ++d_) for (int r = 0; r < 16; ++r) o[d_][r] *= al_l[crow(r, hi)]; } } while (0)
#define KBASE(t) ((j_lo + (t)) * KVBLK)
#define ACT(t) (KBASE(t) <= qlo + QBLK - 1 && KBASE(t) + KVBLK - 1 >= qlo - W + 1)
#define MASKT(P0_, P1_, t) do { const int kb_ = KBASE(t); keepT = true; \
        if (kb_ < cur.P0) { const unsigned selbits = ((const unsigned*)(lds + LDS_BYTES))[tid]; keepT = (selbits >> (kb_ >> 8)) & 1u; }     \
        else if (kb_ + KVBLK - 1 > qlo) mask_tile(P0_, P1_, qm - kb_, (unsigned)W); } while (0)
    constexpr int NQL = F32 ? 16 : 4;
    constexpr bool SK = WSKIP && !F32;
#define SEAM_K0() do { VMWN(NQL); if constexpr (F32) { SWRITE_KF(0); SBAR(); SLOAD_F((const float*)nxt.V, kbn); } else { SWRITE_HK(0); } SBAR(); } while (0)
    f32x16 pA0, pA1, pB0, pB1; float mnA, mnB, alA, alB; bf16x8 pa0, pa1, pa2, pa3;
    if constexpr (F32) { VMW(); SWRITE_VF(0); SBAR(); } else { SWRITE_HV(0); SBAR(); }
    if (NT > 1) { if constexpr (F32) SLOAD_F((const float*)Kh, KBASE(1)); else SLOAD_H(Kh, Vh, KBASE(1)); }
    SBAR(); qkt<0, SK>(pA0, pA1, K_lds, r32, hi, S.qr, ACT(0));
    if constexpr (F32) { if (NT > 1) { VMW(); SWRITE_KF(1); SBAR(); SLOAD_F((const float*)Vh, KBASE(1)); } }
    bool keepT = true;
    MASKT(pA0, pA1, 0); partialSM(pA0, pA1, m_reg, mnA, alA, keepT);
    if (NT > 1) { VMW(); if constexpr (F32) { SWRITE_VF(1); SBAR(); if (NT > 2) SLOAD_F((const float*)Kh, KBASE(2)); } else SWRITE_H(1); }
    __syncthreads();
#define HALF_STEP(PX0, PX1, mnX, alX, PY0, PY1, alY, t, KB, VB, SB) do {                                                      \
        SBAR(); qkt<KB, SK>(PX0, PX1, K_lds, r32, hi, S.qr, ACT(t));                                             \
        finishSM(PY0, PY1, alY, l_reg, pa0, pa1, pa2, pa3); SBAR();                                                           \
        if ((t) + 1 < NT) { if constexpr (F32) { VMW(); SWRITE_KF(SB); SBAR(); SLOAD_F((const float*)Vh, KBASE((t) + 1)); }  \
                            else { SLOAD_H(Kh, Vh, KBASE((t) + 1)); } SBAR(); }                                               \
        pv_tile<VB, SK>(o, vb0, pa0, pa1, pa2, pa3, ACT((t) - 1)); MASKT(PX0, PX1, (t)); partialSM(PX0, PX1, m_reg, mnX, alX, keepT);                                        \
        __syncthreads();                                                                                                      \
        if ((t) + 1 < NT) { VMW(); if constexpr (F32) { SWRITE_VF(SB); SBAR(); if ((t) + 2 < NT) SLOAD_F((const float*)Kh, KBASE((t) + 2)); } \
                            else { SWRITE_H(SB); } }                                                                          \
        RESC(alX); __syncthreads(); } while (0)
    for (int t = 1; t + 1 < NT; t += 2) {
        HALF_STEP(pB0, pB1, mnB, alB, pA0, pA1, alA, t, 1, 0, 0);
        HALF_STEP(pA0, pA1, mnA, alA, pB0, pB1, alB, t + 1, 0, 1, 1);
    }
    const bool even = (NT & 1) == 0;
    if (even) { SBAR(); qkt<1, SK>(pB0, pB1, K_lds, r32, hi, S.qr, ACT(NT - 1)); SBAR(); }
#define QROW(e) (nxt.Q + (size_t)(wid * QBLK + r32) * D + ((e) >> 1) * 16 + hi * 8 + ((e) & 1) * 4)
    if constexpr (F32) { SLOAD_F((const float*)nxt.K, kbn); SBAR();
#pragma unroll
        for (int e = 0; e < 8; ++e) S.tq[e] = *(const f32x4*)QROW(e); }
    else { int sr_ = sr, sc_ = sc; asm volatile("" : "+v"(sr_), "+v"(sc_)); { const int sr = sr_, sc = sc_; SLOAD_H(nxt.K8, nxt.V, kbn); } SBAR();
#pragma unroll
        for (int d0 = 0; d0 < 1; ++d0) { const unsigned char* q8 = nxt.Q8 + (size_t)(wid * QBLK + r32) * 128 + hi * 32; S.qr[0] = *(const bf16x8*)q8; S.qr[1] = *(const bf16x8*)(q8 + 16); S.qr[2] = *(const bf16x8*)(q8 + 64); S.qr[3] = *(const bf16x8*)(q8 + 80); } }
    SBAR();
    finishSM(pA0, pA1, alA, l_reg, pa0, pa1, pa2, pa3); SBAR();
    if constexpr (F32) {
#pragma unroll
        for (int e = 8; e < 16; ++e) S.tq[e] = *(const f32x4*)QROW(e); SBAR(); }
#undef QROW
    pv_tile<0, SK>(o, vb0, pa0, pa1, pa2, pa3, ACT(even ? NT - 2 : NT - 1));
    if (even) { MASKT(pB0, pB1, NT - 1); partialSM(pB0, pB1, m_reg, mnB, alB, keepT); __syncthreads(); RESC(alB);
        finishSM(pB0, pB1, alB, l_reg, pa0, pa1, pa2, pa3); SBAR(); pv_tile<1, SK>(o, vb0, pa0, pa1, pa2, pa3, ACT(NT - 1)); }
    SBAR(); SEAM_K0();
    if (hi == 0) li_l[r32] = l_reg; asm volatile("s_waitcnt lgkmcnt(0)" ::: "memory");
    float rli[16];
#pragma unroll
    for (int r = 0; r < 16; ++r) rli[r] = __builtin_amdgcn_rcpf(li_l[crow(r, hi)]);
    unsigned char* Ow8 = (unsigned char*)cur.O + (size_t)(wid * QBLK) * OSTR;
#pragma unroll
    for (int r = 0; r < 16; ++r) { const int orow = crow(r, hi);
#pragma unroll
        for (int d0 = 0; d0 < 4; ++d0) { const float v = o[d0][r] * rli[r];
            const float v64 = v * 64.0f, vb = __shfl_xor(v64, 1), vc = __shfl_xor(v64, 2), vd = __shfl_xor(vb, 2);
            if ((r32 & 3) == 0) *(unsigned*)(Ow8 + (size_t)orow * OSTR + d0 * 32 + r32) = pk4_fp8(v64, vb, vc, vd); } }
    if constexpr (F32) {
#pragma unroll
        for (int d0 = 0; d0 < 8; ++d0) S.qr[d0] = pack8(S.tq[2 * d0], S.tq[2 * d0 + 1]); }
    __syncthreads();
#undef RESC
#undef KBASE
#undef ACT
#undef MASKT
#undef SEAM_K0
#undef HALF_STEP
}
#undef ROW
#undef VMW
#undef VMWN
#undef SLOAD_H
#undef SWRITE_HK
#undef SWRITE_HV
#undef SWRITE_H
#undef SLOAD_F
#undef SWRITE_KF
#undef SWRITE_VF

#undef KSWZ
#undef KSWZ8
#undef SBAR
}

__device__ __forceinline__ void attn_phase(Frame& F) {
    if (F.bid >= 144) return;
    typedef att::BlockRef<bf16, bf16> Ref;
    const int bh = F.bid & 15, y = F.bid >> 4, b = bh >> 3, h = bh & 7;
    const bf16* MQ = wsp<bf16>(F, WS_MQ) + (size_t)bh * 4096 * 128; const bf16* MK = wsp<bf16>(F, WS_MK) + (size_t)bh * 4096 * 128; const bf16* MV = wsp<bf16>(F, WS_MV) + (size_t)bh * 4096 * 128;
    bf16* OA = (bf16*)(F.ws + WS_OA + (size_t)b * 4096 * 1024 + h * 128);        const float* KM = wsp<float>(F, OFF_KMEAN) + (size_t)bh * 16 * 128;
    const bool single = (y == 0) || (y == 8); const int q0 = y == 0 ? 15 : (y == 8 ? 7 : y - 1), q1 = single ? q0 : 15 - y;
    const unsigned char* MQ8 = F.ws + WS_MQ8 + (size_t)bh * 4096 * 128; const unsigned char* MK8 = F.ws + WS_MK8 + (size_t)bh * 4096 * 128;
    const Ref r0{MQ + (size_t)q0 * 256 * 128, MK, MV, (bf16*)((unsigned char*)OA + (size_t)q0 * 256 * 1024), q0 * 256, KM, MQ8 + (size_t)q0 * 256 * 128, MK8};
    const Ref r1{MQ + (size_t)q1 * 256 * 128, MK, MV, (bf16*)((unsigned char*)OA + (size_t)q1 * 256 * 1024), q1 * 256, KM, MQ8 + (size_t)q1 * 256 * 128, MK8};
    att::Seam<bf16> S;
    char* lds = (char*)F.ldsg;
    ((LAS f32x4*)(F.lds + att::LDS_BYTES + 4096))[F.tid] = ((const GAS f32x4*)KM)[F.tid] + ((const GAS f32x4*)(wsp<float>(F, WS_KMEAN1) + (size_t)bh * 16 * 128))[F.tid];
    __syncthreads();
    att::causal_swa_prime<bf16, bf16>(r0, 1 << 30, lds, S);
    att::causal_swa_block<bf16, bf16>(r0, r1, 4096, 1 << 30, lds, S);
    if (!single) att::causal_swa_block<bf16, bf16>(r1, r1, 4096, 1 << 30, lds, S);
    VM_WAIT(); __syncthreads();
}


namespace ret {
constexpr int PITCH = 272, TILE = 128 * PITCH;
constexpr int QS = 0, KS = TILE, PS = 2 * TILE, ST = 3 * TILE, YT = 0, YPITCH = 528;
static_assert(128 * YPITCH <= 2 * TILE && ST + 8192 <= RING_BYTES, "retention LDS map");
typedef short s16x4 __attribute__((ext_vector_type(4)));
typedef short v4i16_t __attribute__((ext_vector_type(4)));
__device__ __forceinline__ s16x4 vtr(LAS const unsigned char* p) { return __builtin_bit_cast(s16x4, __builtin_amdgcn_ds_read_tr16_b64_v4i16((LAS v4i16_t*)p)); }
#define RMFMA(a, b, c) __builtin_amdgcn_mfma_f32_32x32x16_bf16((a), (b), (c), 0, 0, 0)
__device__ __forceinline__ bf16x8 pack_step(const f32x16& x, int s) {
    u32x4 w; w.x = pk2(x[8 * s], x[8 * s + 1]); w.y = pk2(x[8 * s + 2], x[8 * s + 3]); w.z = pk2(x[8 * s + 4], x[8 * s + 5]); w.w = pk2(x[8 * s + 6], x[8 * s + 7]);
    return __builtin_bit_cast(bf16x8, w);
}
__device__ __forceinline__ void retention_item(Frame& F, const Args& A, int bh, int seg) {
    LAS unsigned char* lds = F.lds;
    const int tid = F.tid, lane = F.lane, w = F.wave, r = lane & 31, h = lane >> 5;
    const int head = bh & 7, b = bh >> 3;
    const bf16* RQ = wsp<bf16>(F, WS_RQ) + (size_t)bh * 4096 * 128; const bf16* RK = wsp<bf16>(F, WS_RK) + (size_t)bh * 4096 * 128;
    const bf16* RVT = wsp<bf16>(F, WS_RVT) + ((size_t)bh * 256 + 32 * w + r) * 4096 + 8 * h;
    const bf16* RG = wsp<bf16>(F, WS_RG); bf16* YR = wsp<bf16>(F, WS_YR);
    const float nlg = -log2f(1.0f - exp2f(-(5.0f + (float)head)));
    const float cd = exp2f(-128.0f * nlg);
    f32x16 R[4];
#pragma unroll
    for (int d = 0; d < 4; ++d)
#pragma unroll
        for (int i = 0; i < 16; ++i) R[d][i] = 0.f;
    const int n0 = seg == 0 ? 0 : (seg == 1 ? 11 : (seg == 2 ? 20 : 27)), nend = seg == 0 ? 11 : (seg == 1 ? 20 : (seg == 2 ? 27 : 32));
    u32x4 stq[4], stk[4];
    const int srow = tid >> 4, sch = tid & 15;
    const unsigned swr = (unsigned)(srow * PITCH + sch * 16);
#define RLOADK(n) do { _Pragma("unroll") for (int k_ = 0; k_ < 4; ++k_) stk[k_] = *(const GAS u32x4*)(RK + ((size_t)(n) * 128 + srow + 32 * k_) * 128 + sch * 8); } while (0)
#define RLOADQ(n) do { _Pragma("unroll") for (int k_ = 0; k_ < 4; ++k_) stq[k_] = __builtin_nontemporal_load((const GAS u32x4*)(RQ + ((size_t)(n) * 128 + srow + 32 * k_) * 128 + sch * 8)); } while (0)
#define RWRITEK() do { _Pragma("unroll") for (int k_ = 0; k_ < 4; ++k_) *(LAS u32x4*)(lds + KS + swr + k_ * 32 * PITCH) = stk[k_]; } while (0)
#define RWRITEQ() do { _Pragma("unroll") for (int k_ = 0; k_ < 4; ++k_) *(LAS u32x4*)(lds + QS + swr + k_ * 32 * PITCH) = stq[k_]; } while (0)
    RLOADK(0); if (n0 == 0) RLOADQ(0);
    RWRITEK(); if (n0 == 0) RWRITEQ();
    __syncthreads();
    const int d8 = tid & 31; f32x4 gw0, gw1;
    { const GAS f32x4* gp = (const GAS f32x4*)(A.in[I_GN_W] + head * 256 + d8 * 8); gw0 = gp[0]; gw1 = gp[1]; }
    const unsigned nat = (unsigned)(r * PITCH + h * 16), prm = (unsigned)(r * PITCH + h * 8);
    const unsigned trb = (unsigned)((8 * h + ((lane & 15) >> 2)) * PITCH + ((lane >> 4) & 1) * 32 + (lane & 3) * 8);
#define RVLOAD(n) do { _Pragma("unroll") for (int ks = 0; ks < 8; ++ks) vfr[ks] = *(const GAS bf16x8*)(RVT + (size_t)(n) * 128 + ks * 16); } while (0)
#define RUPDATE() do { _Pragma("unroll") for (int ks = 0; ks < 8; ++ks) { \
            _Pragma("unroll") for (int d = 0; d < 4; ++d) { LAS const unsigned char* kp = lds + KS + trb + ks * 16 * PITCH + d * 64; \
                const s16x4 lo = vtr(kp); const s16x4 hi4 = vtr(kp + 4 * PITCH); \
                const bf16x8 ka = __builtin_shufflevector(lo, hi4, 0, 1, 2, 3, 4, 5, 6, 7); \
                R[d] = RMFMA(ka, vfr[ks], R[d]); }                   \
            if (ks & 1) __builtin_amdgcn_sched_barrier(0); } \
        _Pragma("unroll") for (int d = 0; d < 4; ++d) { _Pragma("unroll") for (int i = 0; i < 16; ++i) R[d][i] *= cd; } \
        __builtin_amdgcn_sched_barrier(0); } while (0)
    if (n0 > 0) {
        bf16x8 vfr[8], vnx[8]; RVLOAD(0);
        for (int n = 0; n < n0; ++n) {
            RLOADK(n + 1); if (n + 1 == n0) RLOADQ(n + 1);
            if (n + 1 < n0) {
#pragma unroll
                for (int ks = 0; ks < 8; ++ks) vnx[ks] = *(const GAS bf16x8*)(RVT + (size_t)(n + 1) * 128 + ks * 16); }
            __builtin_amdgcn_sched_barrier(0);
            RUPDATE();
            __builtin_amdgcn_sched_barrier(0);
            __syncthreads();
            RWRITEK(); if (n + 1 == n0) RWRITEQ();
            __syncthreads();
#pragma unroll
            for (int ks = 0; ks < 8; ++ks) vfr[ks] = vnx[ks];
        }
    }
    for (int n = n0; n < nend; ++n) {
        const bool has_next = (n + 1) < nend;
        bf16x8 vfr[8]; RVLOAD(n);
        f32x16 O[4];
        {
            const int it = w >> 1;
#pragma unroll
            for (int jj = 0; jj < 2; ++jj) { const int jt = 2 * (w & 1) + jj;
                if (jt <= it) {
                    f32x16 x;
#pragma unroll
                    for (int i = 0; i < 16; ++i) x[i] = 0.f;
                    LAS const unsigned char* ka = lds + KS + nat + jt * 32 * PITCH; LAS const unsigned char* qa = lds + QS + nat + it * 32 * PITCH;
#pragma unroll
                    for (int s = 0; s < 8; ++s) { const bf16x8 a = *(const LAS bf16x8*)(ka + s * 32); const bf16x8 bq = *(const LAS bf16x8*)(qa + s * 32); x = RMFMA(a, bq, x); }
                    if (jt == it) {
#pragma unroll
                        for (int i = 0; i < 16; ++i) { const int jl = (i & 3) + 8 * (i >> 2) + 4 * h; x[i] = jl <= r ? x[i] : 0.f; } }
                    LAS unsigned char* pw = lds + PS + prm + it * 32 * PITCH + jt * 64;
#pragma unroll
                    for (int g = 0; g < 4; ++g) { u32x2 v; v.x = pk2(x[4 * g], x[4 * g + 1]); v.y = pk2(x[4 * g + 2], x[4 * g + 3]); *(LAS u32x2*)(pw + g * 16) = v; }
                } }
            __syncthreads();
#pragma unroll
            for (int t = 0; t < 4; ++t)
#pragma unroll
                for (int i = 0; i < 16; ++i) O[t][i] = 0.f;
#pragma unroll
            for (int kx = 0; kx < 8; ++kx) {
#pragma unroll
                for (int t = 0; t < 4; ++t) if (kx < 2 * t + 2) { const bf16x8 pb = *(const LAS bf16x8*)(lds + PS + nat + t * 32 * PITCH + kx * 32); O[t] = RMFMA(vfr[kx], pb, O[t]); }
                if (kx & 1) __builtin_amdgcn_sched_barrier(0); }
#pragma unroll
            for (int d = 0; d < 4; ++d)
#pragma unroll
                for (int s = 0; s < 2; ++s) { const bf16x8 ra = pack_step(R[d], s);
#pragma unroll
                    for (int t = 0; t < 4; ++t) { LAS const unsigned char* qp = lds + QS + prm + t * 32 * PITCH + d * 64 + s * 32; const u32x2 lo = *(const LAS u32x2*)qp, hi2 = *(const LAS u32x2*)(qp + 16);
                        u32x4 qb; qb.x = lo.x; qb.y = lo.y; qb.z = hi2.x; qb.w = hi2.y; O[t] = RMFMA(ra, __builtin_bit_cast(bf16x8, qb), O[t]); }
                    __builtin_amdgcn_sched_barrier(0); }
        }
        RUPDATE();
        __builtin_amdgcn_sched_barrier(0);
        if (has_next) { RLOADK(n + 1); RLOADQ(n + 1); }
        u32x4 gpre[8];
        { const size_t tok0p = (size_t)b * 4096 + (size_t)n * 128;
#pragma unroll
          for (int k_ = 0; k_ < 8; ++k_) gpre[k_] = __builtin_nontemporal_load((const GAS u32x4*)(RG + (tok0p + (tid >> 5) + 16 * k_) * 2048 + head * 256 + (tid & 31) * 8)); }
        {
            LAS float* st = (LAS float*)(lds + ST);
#pragma unroll
            for (int t = 0; t < 4; ++t) { const float sc = exp2f(-(float)(32 * t + r + 1) * nlg); float s1 = 0.f, s2 = 0.f;
#pragma unroll
                for (int i = 0; i < 16; ++i) { O[t][i] *= sc; s1 += O[t][i]; s2 = fmaf(O[t][i], O[t][i], s2); }
                s1 += __shfl_xor(s1, 32); s2 += __shfl_xor(s2, 32);
                if (h == 0) { st[(w * 128 + 32 * t + r) * 2] = s1; st[(w * 128 + 32 * t + r) * 2 + 1] = s2; } }
        }
        __syncthreads();
        {
            const LAS float* st = (const LAS float*)(lds + ST);
#pragma unroll
            for (int t = 0; t < 4; ++t) { float s1 = 0.f, s2 = 0.f;
#pragma unroll
                for (int ww = 0; ww < 8; ++ww) { s1 += st[(ww * 128 + 32 * t + r) * 2]; s2 += st[(ww * 128 + 32 * t + r) * 2 + 1]; }
                const float mu = s1 * (1.0f / 256.0f), var = fmaxf(s2 * (1.0f / 256.0f) - mu * mu, 0.f), rstd = 1.0f / sqrtf(var + GN_EPS);
                LAS unsigned char* yw = lds + YT + (32 * t + r) * YPITCH + (32 * w + 4 * h) * 2;
#pragma unroll
                for (int g = 0; g < 4; ++g) { u32x2 v; v.x = pk2((O[t][4 * g] - mu) * rstd, (O[t][4 * g + 1] - mu) * rstd); v.y = pk2((O[t][4 * g + 2] - mu) * rstd, (O[t][4 * g + 3] - mu) * rstd);
                    *(LAS u32x2*)(yw + g * 16) = v; } }
            __syncthreads();
            const size_t tok0 = (size_t)b * 4096 + (size_t)n * 128;
#pragma unroll
            for (int k_ = 0; k_ < 8; ++k_) { const int tl = (tid >> 5) + 16 * k_; const u32x4 y = *(const LAS u32x4*)(lds + YT + tl * YPITCH + d8 * 16);
                const size_t go = (tok0 + tl) * 2048 + head * 256 + d8 * 8; const u32x4 g = gpre[k_];
                f32x4 o0, o1; o0.x = bf_lo(y.x) * gw0.x * bf_lo(g.x); o0.y = bf_hi(y.x) * gw0.y * bf_hi(g.x); o0.z = bf_lo(y.y) * gw0.z * bf_lo(g.y); o0.w = bf_hi(y.y) * gw0.w * bf_hi(g.y);
                o1.x = bf_lo(y.z) * gw1.x * bf_lo(g.z); o1.y = bf_hi(y.z) * gw1.y * bf_hi(g.z); o1.z = bf_lo(y.w) * gw1.z * bf_lo(g.w); o1.w = bf_hi(y.w) * gw1.w * bf_hi(g.w);
                { u32x2 y8;
#define Y8C(v_) __builtin_amdgcn_fmed3f((v_) * 8.0f, -448.0f, 448.0f)
                  y8.x = pk4_fp8(Y8C(o0.x), Y8C(o0.y), Y8C(o0.z), Y8C(o0.w)); y8.y = pk4_fp8(Y8C(o1.x), Y8C(o1.y), Y8C(o1.z), Y8C(o1.w));
#undef Y8C
                  *(GAS u32x2*)((unsigned char*)YR + go) = y8; } }
            __syncthreads();
        }
        if (has_next) { RWRITEK(); RWRITEQ(); }
        __syncthreads();
    }
#undef RVLOAD
#undef RUPDATE
#undef RLOADK
#undef RLOADQ
#undef RWRITEK
#undef RWRITEQ
}
#undef RMFMA
}
__device__ __forceinline__ void retention_phase(Frame& F, const Args& A) {
    if (F.bid < 144 || F.bid >= 208) return;
    const int idx = F.bid - 144;
    ret::retention_item(F, A, idx & 15, idx >> 4);
}

struct SchedDense {
    static constexpr bool GATHER = false, LITE = false;
    int G, c; const char* ws; unsigned offA, offW, ts;
    __device__ __forceinline__ bool next(int i, Unit& u) const { const int L = i * G + c; if (L >= 256) return false; int pm, pn; pg8::tile_of(L, 32, 8, pm, pn); u.pm = pm; u.pn = pn; u.kind = 0; u.aux = 0; u.slot = i; return true; }
    __device__ __forceinline__ void ptrs(const Unit& u, unsigned& a, unsigned& b) const { a = offA + (unsigned)u.pm * ts; b = offW + (unsigned)u.pn * ts; }
    __device__ __forceinline__ int arow(int, int) const { return 0; }
};
struct EpiMixA {
    unsigned char* ws;
    __device__ __forceinline__ void operator()(AccRef acc, const Unit& u, int wr, int wc, int fr, int fq) const {
        asm volatile("" : "+v"(fr), "+v"(fq));
        const unsigned char* GA = ws + WS_GA; unsigned char* MIXA = ws + WS_MIXA;
        constexpr int PF = 4; u32x4 gb[8];
#define MX_OFF(st_) ((size_t)(u.pm * 256 + ((st_) >> 2) * 128 + wr * 64 + ((st_) & 3) * 16 + fr) * 2048 + u.pn * 256 + wc * 64 + 16 * fq)
#pragma unroll
        for (int st = 0; st < PF; ++st) gb[st] = *(const GAS u32x4*)(GA + MX_OFF(st));
#pragma unroll
        for (int st = 0; st < 8; ++st) { const int ai = st >> 2, m = st & 3; const size_t off = MX_OFF(st);
                if (st + PF < 8) gb[st + PF] = *(const GAS u32x4*)(GA + MX_OFF(st + PF));
                __builtin_amdgcn_sched_barrier(0);
                const u32x4 g = gb[st]; u32x4 o;
#pragma unroll
                for (int bj = 0; bj < 2; ++bj) { const f32x4 g0 = unpk4_fp8(bj ? g.z : g.x), g1 = unpk4_fp8(bj ? g.w : g.y);
                    const f32x4 v0 = acc[ai][bj][m][0] * (1.0f / 32.0f) * g0, v1 = acc[ai][bj][m][1] * (1.0f / 32.0f) * g1;
                    const unsigned p0 = pk4_fp8(v0.x, v0.y, v0.z, v0.w), p1 = pk4_fp8(v1.x, v1.y, v1.z, v1.w);
                    if (bj) { o.z = p0; o.w = p1; } else { o.x = p0; o.y = p1; } }
                *(GAS u32x4*)(MIXA + off) = o; }
#undef MX_OFF
    }
};
constexpr float MIX_SCALE = 85.0f;
struct EpiMixB {
    unsigned char* ws;
    __device__ __forceinline__ void operator()(AccRef acc, const Unit& u, int wr, int wc, int fr, int fq) const {
        asm volatile("" : "+v"(fr), "+v"(fq));
        const bf16* GR = (const bf16*)(ws + WS_GR); const unsigned char* MIXA = ws + WS_MIXA; unsigned char* MIX = ws + WS_MIX;
        constexpr int PF = 3; u32x4 ab[8], gb[8][2];
#define MX_OFF(st_) ((size_t)(u.pm * 256 + ((st_) >> 2) * 128 + wr * 64 + ((st_) & 3) * 16 + fr) * 2048 + u.pn * 256 + wc * 64 + 16 * fq)
#define MX_LD(st_) do { const size_t o_ = MX_OFF(st_); ab[st_] = *(const GAS u32x4*)(MIXA + o_); gb[st_][0] = *(const GAS u32x4*)(GR + o_); gb[st_][1] = *(const GAS u32x4*)(GR + o_ + 8); } while (0)
#pragma unroll
        for (int st = 0; st < PF; ++st) MX_LD(st);
#pragma unroll
        for (int st = 0; st < 8; ++st) { const int ai = st >> 2, m = st & 3; const size_t off = MX_OFF(st);
                if (st + PF < 8) MX_LD(st + PF);
                __builtin_amdgcn_sched_barrier(0);
                const u32x4 a8 = ab[st]; u32x4 o;
#pragma unroll
                for (int bj = 0; bj < 2; ++bj) { const u32x4 g = gb[st][bj]; const f32x4 a0 = unpk4_fp8(bj ? a8.z : a8.x) * (1.0f / 64.0f), a1 = unpk4_fp8(bj ? a8.w : a8.y) * (1.0f / 64.0f); f32x4 v0 = acc[ai][bj][m][0] * (1.0f / 256.0f), v1 = acc[ai][bj][m][1] * (1.0f / 256.0f);
                    v0.x = fmaf(v0.x, bf_lo(g.x), a0.x); v0.y = fmaf(v0.y, bf_hi(g.x), a0.y); v0.z = fmaf(v0.z, bf_lo(g.y), a0.z); v0.w = fmaf(v0.w, bf_hi(g.y), a0.w);
                    v1.x = fmaf(v1.x, bf_lo(g.z), a1.x); v1.y = fmaf(v1.y, bf_hi(g.z), a1.y); v1.z = fmaf(v1.z, bf_lo(g.w), a1.z); v1.w = fmaf(v1.w, bf_hi(g.w), a1.w);
#pragma unroll
                    for (int j = 0; j < 4; ++j) { v0[j] = __builtin_amdgcn_fmed3f(v0[j] * MIX_SCALE, -127.0f, 127.0f); v1[j] = __builtin_amdgcn_fmed3f(v1[j] * MIX_SCALE, -127.0f, 127.0f); }
                    const unsigned p0 = pk4_i8(v0.x, v0.y, v0.z, v0.w), p1 = pk4_i8(v1.x, v1.y, v1.z, v1.w); if (bj) { o.z = p0; o.w = p1; } else { o.x = p0; o.y = p1; } }
                *(GAS u32x4*)(MIX + off) = o; }
#undef MX_LD
#undef MX_OFF
    }
};
struct EpiOut {
    const float* X; unsigned char* ws; bool skip_at;
    __device__ __forceinline__ void operator()(AccRef acc, const Unit& u, int wr, int wc, int fr, int fq) const {
        asm volatile("" : "+v"(fr), "+v"(fq));
        bf16* X1B = (bf16*)(ws + WS_X1B); float* SSQP = (float*)(ws + WS_SSQP);
        constexpr int PF = 4;
        f32x4 xb[16][2];
#define EO_OFF(st_) ((size_t)(u.pm * 256 + ((st_) >> 3) * 128 + wr * 64 + (((st_) >> 1) & 3) * 16 + fr) * 2048 + u.pn * 256 + wc * 32 + 8 * fq + ((st_) & 1) * 128)
#define EO_LD(st_) do { const GAS f32x4* xp_ = (const GAS f32x4*)(X + EO_OFF(st_)); xb[st_][0] = xp_[0]; xb[st_][1] = xp_[1]; } while (0)
#pragma unroll
        for (int st = 0; st < PF; ++st) EO_LD(st);
        float ss = 0.f;
#pragma unroll
        for (int st = 0; st < 16; ++st) {
            if (st + PF < 16) EO_LD(st + PF);
            __builtin_amdgcn_sched_barrier(0);
            const int ai = st >> 3, m = (st >> 1) & 3, bj = st & 1; const size_t off = EO_OFF(st);
            const f32x4 v0 = acc[ai][bj][m][0] * (1.0f / (MIX_SCALE * W_IN_SCALE)) + xb[st][0], v1 = acc[ai][bj][m][1] * (1.0f / (MIX_SCALE * W_IN_SCALE)) + xb[st][1];
            *(GAS u32x4*)(X1B + off) = pack8(v0, v1);
            { u32x2 o8; o8.x = pk4_fp8(v0.x, v0.y, v0.z, v0.w); o8.y = pk4_fp8(v1.x, v1.y, v1.z, v1.w); *(GAS u32x2*)(ws + WS_X1B8 + off) = o8; }
            ss += (v0.x * v0.x + v0.y * v0.y) + (v0.z * v0.z + v0.w * v0.w) + (v1.x * v1.x + v1.y * v1.y) + (v1.z * v1.z + v1.w * v1.w);
            if (bj == 1) { ss += __shfl_xor(ss, 16); ss += __shfl_xor(ss, 32);
                if (fq == 0) SSQP[(size_t)(u.pn * 4 + wc) * 8192 + u.pm * 256 + ai * 128 + wr * 64 + m * 16 + fr] = ss;
                ss = 0.f; }
        }
#undef EO_LD
#undef EO_OFF
    }
};

__device__ __forceinline__ void router_phase(Frame& F, const Args& A) {
    const bf16* X1B = wsp<bf16>(F, WS_X1B); const bf16* WRT = wsp<bf16>(F, WS_WRT); const float* SSQP = wsp<float>(F, WS_SSQP);
    unsigned* CNT = wsp<unsigned>(F, OFF_CNT); unsigned* LISTTOK = wsp<unsigned>(F, WS_LISTTOK); float* LISTW = wsp<float>(F, WS_LISTW); float* RSTD = wsp<float>(F, WS_RSTD);
    LAS float* part = (LAS float*)F.lds;
    LAS float* logit = (LAS float*)(F.lds + 65536);
    LAS float* ssl = (LAS float*)(F.lds + 65536 + 8192);
    const int lane = F.lane, w = F.wave, r32 = lane & 31, hi = lane >> 5;
    LAS float* bl = (LAS float*)(F.lds + 65536 + 8192 + 2048);
    if (F.tid < 4) bl[F.tid] = A.in[I_B_RG][F.tid]; else if (F.tid < 36) bl[F.tid] = A.in[I_B_RE][F.tid - 4];
    for (int rt = F.bid; rt < T / 32; rt += F.G) {
        const int row0 = rt * 32;
        f32x16 a0, a1;
#pragma unroll
        for (int i = 0; i < 16; ++i) { a0[i] = 0.f; a1[i] = 0.f; }
        const bf16* ap = X1B + (size_t)(row0 + r32) * 2048 + w * 256 + hi * 8; const bf16* bp0 = WRT + (size_t)r32 * 2048 + w * 256 + hi * 8; const bf16* bp1 = bp0 + (size_t)32 * 2048;
#pragma unroll 8
        for (int ks = 0; ks < 16; ++ks) { const bf16x8 a = *(const GAS bf16x8*)(ap + ks * 16), b0 = *(const GAS bf16x8*)(bp0 + ks * 16), b1 = *(const GAS bf16x8*)(bp1 + ks * 16);
            a0 = __builtin_amdgcn_mfma_f32_32x32x16_bf16(a, b0, a0, 0, 0, 0); a1 = __builtin_amdgcn_mfma_f32_32x32x16_bf16(a, b1, a1, 0, 0, 0); }
#pragma unroll
        for (int i = 0; i < 16; ++i) { const int row = (i & 3) + 8 * (i >> 2) + 4 * hi; part[(w * 32 + row) * 64 + r32] = a0[i]; part[(w * 32 + row) * 64 + 32 + r32] = a1[i]; }
        { const int tk = F.tid & 31, pp = F.tid >> 5; ssl[pp * 32 + tk] = SSQP[(size_t)pp * 8192 + row0 + tk] + SSQP[(size_t)(pp + 16) * 8192 + row0 + tk]; }
        __syncthreads();
        for (int e = F.tid; e < 2048; e += 512) { float s = 0.f;
#pragma unroll
            for (int ww = 0; ww < 8; ++ww) s += part[ww * 2048 + e];
            logit[e] = s; }
        __syncthreads();
        if (F.tid < 32) {
            const int t = row0 + F.tid; const LAS float* lg = logit + F.tid * 64;
            float ssq = 0.f;
#pragma unroll
            for (int pp = 0; pp < 16; ++pp) ssq += ssl[pp * 32 + F.tid];
            const float rstd = 1.0f / sqrtf(ssq * (1.0f / DM) + RMS_EPS);
            float gl[4]; float gm = -__builtin_inff(); int gi = 0;
#pragma unroll
            for (int j = 0; j < 4; ++j) { gl[j] = lg[j] * rstd + bl[j]; if (gl[j] > gm) { gm = gl[j]; gi = j; } }
            float gs = 0.f;
#pragma unroll
            for (int j = 0; j < 4; ++j) gs += __expf(gl[j] - gm);
            const float gw = 1.0f / gs;
            float el[8]; float em = -__builtin_inff();
#pragma unroll
            for (int j = 0; j < 8; ++j) { el[j] = lg[4 + gi * 8 + j] * rstd + bl[4 + gi * 8 + j]; em = fmaxf(em, el[j]); }
            int i1 = 0; float p1 = -1.f;
#pragma unroll
            for (int j = 0; j < 8; ++j) { el[j] = __expf(el[j] - em); if (el[j] > p1) { p1 = el[j]; i1 = j; } }
            int i2 = 0; float p2 = -1.f;
#pragma unroll
            for (int j = 0; j < 8; ++j) if (j != i1 && el[j] > p2) { p2 = el[j]; i2 = j; }
            const float inv = 1.0f / (p1 + p2);
            const int e1 = gi * 8 + i1, e2 = gi * 8 + i2;
            LAS unsigned* cl = (LAS unsigned*)(F.lds + MISC_OFF + 2304);
            volatile LAS unsigned* clv = cl;
            clv[F.tid] = 0u; __builtin_amdgcn_wave_barrier();
            const unsigned r1 = __hip_atomic_fetch_add(cl + e1, 1u, __ATOMIC_RELAXED, __HIP_MEMORY_SCOPE_WORKGROUP), r2 = __hip_atomic_fetch_add(cl + e2, 1u, __ATOMIC_RELAXED, __HIP_MEMORY_SCOPE_WORKGROUP);
            __builtin_amdgcn_wave_barrier();
            { const unsigned c_ = clv[F.tid]; clv[32 + F.tid] = c_ ? atomicAdd(CNT + (rt & 15) * 32 + F.tid, c_) : 0u; }
            __builtin_amdgcn_wave_barrier();
            const unsigned q1 = (unsigned)(rt & 15) * 512u + clv[32 + e1] + r1, q2 = (unsigned)(rt & 15) * 512u + clv[32 + e2] + r2;
            LISTTOK[e1 * 8192 + q1] = (unsigned)t; LISTW[e1 * 8192 + q1] = gw * p1 * inv;
            LISTTOK[e2 * 8192 + q2] = (unsigned)t | 0x10000u; LISTW[e2 * 8192 + q2] = gw * p2 * inv;
            RSTD[t] = rstd;
        }
        __syncthreads();
    }
}

constexpr int PRE_OFF = MISC_OFF + 10240;
__device__ __forceinline__ void build_tables(Frame& F) {
    LAS int* tb = (LAS int*)(F.lds + MISC_OFF); LAS int* cg = (LAS int*)(F.lds + PRE_OFF); LAS int* pre = cg + 512;
    { const unsigned* CNT = wsp<unsigned>(F, OFF_CNT); cg[(F.tid & 31) * 16 + (F.tid >> 5)] = (int)__hip_atomic_load(CNT + F.tid, __ATOMIC_RELAXED, __HIP_MEMORY_SCOPE_AGENT); }
    __syncthreads();
    if (F.tid < 64) { const int e = F.tid & 31; int c = 0;
#pragma unroll
        for (int g = 0; g < 16; ++g) { if (F.tid < 32) pre[e * 16 + g] = c; c += cg[e * 16 + g]; }
        const int pc = (c + 255) & ~255;
        int incl = pc;
#pragma unroll
        for (int o = 1; o < 32; o <<= 1) { const int t = __shfl_up(incl, o, 32); if (e >= o) incl += t; }
        const int rem = c & 255, lt = (rem != 0 && rem <= 128) ? 1 : 0, fl = (pc >> 8) - lt; int fi = fl, li = lt;
#pragma unroll
        for (int o = 1; o < 32; o <<= 1) { const int t1 = __shfl_up(fi, o, 32), t2 = __shfl_up(li, o, 32); if (e >= o) { fi += t1; li += t2; } }
        if (F.tid < 32) { tb[e] = c; tb[32 + e] = incl - pc; tb[72 + e] = fi - fl; tb[112 + e] = li - lt; if (e == 31) { tb[64] = incl; tb[104] = fi; tb[144] = li; } } }
    __syncthreads();
}
__device__ __forceinline__ int list_pos(const LAS int* pre, int e, int idx) {
    int g = 0;
#pragma unroll
    for (int k = 1; k < 16; ++k) if (idx >= pre[e * 16 + k]) g = k;
    return e * 8192 + g * 512 + (idx - pre[e * 16 + g]);
}
constexpr int TOKT_OFF = MISC_OFF + 4096, TOKT_UNITS = 6;
template <bool GATH> struct SchedExpert {
    static constexpr bool GATHER = GATH, LITE = GATH;
    int G, c, NT; const char* ws; unsigned offA, offW, tsA, tsW; int wtiles_per_e; const LAS int* tb; const LAS int* tokt;
    __device__ __forceinline__ bool next(int i, Unit& u) const {
        if constexpr (!GATH) {
            const int nF = tb[104] * NT, nL = tb[144] * NT; int L = i * G + c; if (L >= nF + nL) return false;
            const int lite = L >= nF ? 1 : 0, n = lite ? nL : nF; if (lite) L -= nF;
            { const int q = n / 8, r = n % 8, xcd = L % 8, off = L / 8; L = (xcd < r ? xcd * (q + 1) : r * (q + 1) + (xcd - r) * q) + off; }
            const LAS int* P = tb + (lite ? 112 : 72);
            int e = 0;
            for (int k = 1; k < 32; ++k) if (L >= P[k] * NT) e = k;
            const int q = L - P[e] * NT, fe = tb[72 + e + 1] - tb[72 + e];
            if (lite) { u.aux = fe; u.pn = q; } else { u.aux = q % fe; u.pn = q / fe; }
            u.pm = (tb[32 + e] >> 8) + u.aux; u.kind = e; u.slot = i; u.lite = lite; return true;
        }
        const int total = (tb[64] >> 8) * NT; int L = i * G + c; if (L >= total) return false;
        { const int q = total / 8, r = total % 8, xcd = L % 8, off = L / 8; L = (xcd < r ? xcd * (q + 1) : r * (q + 1) + (xcd - r) * q) + off; }
        int e = 0;
        for (int k = 1; k < 32; ++k) if (L >= (tb[32 + k] >> 8) * NT) e = k;
        const int mt = (tb[32 + e + 1] - tb[32 + e]) >> 8, q = L - (tb[32 + e] >> 8) * NT;
        u.aux = q % mt; u.pm = (tb[32 + e] >> 8) + u.aux; u.pn = q / mt; u.kind = e; u.slot = i; u.lite = (tb[e] - u.aux * 256 <= 128) ? 1 : 0; return true;
    }
    __device__ __forceinline__ void ptrs(const Unit& u, unsigned& a, unsigned& b) const { a = GATH ? offA : offA + (unsigned)u.pm * tsA; b = offW + (unsigned)(u.kind * wtiles_per_e + u.pn) * tsW; }
    __device__ __forceinline__ int arow(int slot, int row) const { return GATH ? tokt[slot * 256 + row] : 0; }
};
__device__ __forceinline__ void fill_unit_tokens(Frame& F, const SchedExpert<true>& S) {
    LAS int* tokt = (LAS int*)(F.lds + TOKT_OFF); const LAS int* tb = (const LAS int*)(F.lds + MISC_OFF); const unsigned* LISTTOK = wsp<unsigned>(F, WS_LISTTOK);
    Unit u;
    for (int i = 0; i < TOKT_UNITS && S.next(i, u); ++i)
        if (F.tid < 256) { const int idx = u.aux * 256 + F.tid; int tok = 0;
            if (idx < tb[u.kind]) { const int pos = list_pos((const LAS int*)(F.lds + PRE_OFF) + 512, u.kind, idx); const unsigned ent = LISTTOK[pos]; tok = (int)(ent & 0xffffu);
                if (u.pn == 0) { wsp<unsigned>(F, WS_DLT)[u.kind * 8192 + idx] = ent; wsp<float>(F, WS_DLW)[u.kind * 8192 + idx] = wsp<float>(F, WS_LISTW)[pos]; } }
            tokt[i * 256 + F.tid] = tok; }
    __syncthreads();
}
struct EpiExp1 {
    unsigned char* ws; const LAS int* tokt; LAS unsigned char* lds;
    __device__ __forceinline__ void operator()(AccRef acc, const Unit& u, int wr, int wc, int fr, int fq) const {
        asm volatile("" : "+v"(fr), "+v"(fq));
        const float* RSTD = (const float*)(ws + WS_RSTD); unsigned char* ACT = ws + WS_ACT;
        LAS float* rsl = (LAS float*)(lds + EPI_HS_OFF);
        { const int t_ = (wr * 4 + wc) * 64 + fq * 16 + fr; if (t_ < 256) rsl[t_] = RSTD[tokt[u.slot * 256 + t_]] * (1.0f / 64.0f); }
        LDS_WAIT(); __builtin_amdgcn_s_barrier();
#pragma unroll
        for (int ai = 0; ai < 2; ++ai)
#pragma unroll
            for (int m = 0; m < 4; ++m) { if (ai == 1 && u.lite) continue;
                const int rl = ai * 128 + wr * 64 + m * 16 + fr; const float rs = rsl[rl];
                f32x4 o[2];
#pragma unroll
                for (int n = 0; n < 2; ++n)
#pragma unroll
                    for (int j = 0; j < 4; ++j) o[n][j] = siluf_(acc[ai][0][m][n][j] * rs) * (acc[ai][1][m][n][j] * rs);
                u32x2 o8; o8.x = pk4_fp8(o[0].x, o[0].y, o[0].z, o[0].w); o8.y = pk4_fp8(o[1].x, o[1].y, o[1].z, o[1].w);
                *(GAS u32x2*)(ACT + (size_t)(u.pm * 256 + rl) * 512 + u.pn * 128 + wc * 32 + 8 * fq) = o8; }
    }
};
struct EpiExp2 {
    unsigned char* ws; const LAS int* tb; LAS unsigned char* lds;
    __device__ __forceinline__ void operator()(AccRef acc, const Unit& u, int wr, int wc, int fr, int fq) const {
        asm volatile("" : "+v"(fr), "+v"(fq));
        const unsigned* LISTTOK = (const unsigned*)(ws + WS_DLT); const float* LISTW = (const float*)(ws + WS_DLW); unsigned char* Y = ws + WS_Y;
        const int cnt = tb[u.kind];
        LAS unsigned* etl = (LAS unsigned*)(lds + EPI_HS_OFF); LAS float* wtl = (LAS float*)(lds + EPI_HS_OFF + 1024);
        { const int t_ = (wr * 4 + wc) * 64 + fq * 16 + fr; if (t_ < 256) { const int i_ = u.aux * 256 + t_; const bool ok_ = i_ < cnt; etl[t_] = ok_ ? LISTTOK[u.kind * 8192 + i_] : 0u; wtl[t_] = ok_ ? LISTW[u.kind * 8192 + i_] * (16.0f / 32.0f) : 0.f; } }
        LDS_WAIT(); __builtin_amdgcn_s_barrier();
#pragma unroll
        for (int ai = 0; ai < 2; ++ai)
#pragma unroll
            for (int m = 0; m < 4; ++m) { const int idx = u.aux * 256 + ai * 128 + wr * 64 + m * 16 + fr;
                if (idx < cnt) { const unsigned ent = etl[ai * 128 + wr * 64 + m * 16 + fr]; const float w = wtl[ai * 128 + wr * 64 + m * 16 + fr]; unsigned char* yp = Y + ((size_t)(ent >> 16) * T + (ent & 0xffffu)) * 2048 + u.pn * 256 + wc * 64 + 16 * fq; u32x4 o8;
#pragma unroll
                    for (int bj = 0; bj < 2; ++bj) { const f32x4 v0 = acc[ai][bj][m][0] * w, v1 = acc[ai][bj][m][1] * w; const unsigned p0 = pk4_fp8(v0.x, v0.y, v0.z, v0.w), p1 = pk4_fp8(v1.x, v1.y, v1.z, v1.w); if (bj) { o8.z = p0; o8.w = p1; } else { o8.x = p0; o8.y = p1; } }
                    *(GAS u32x4*)yp = o8; } }
    }
};
__device__ __forceinline__ void final_phase(Frame& F, const Args& A) {
    const bf16* X1B = wsp<bf16>(F, WS_X1B); const unsigned char* Y = F.ws + WS_Y;
    const int gw = F.bid * 8 + F.wave, NGW = F.G * 8, lane = F.lane;
    f32x4 w[8];
    { const GAS f32x4* wr = (const GAS f32x4*)A.in[I_NORM_FINAL] + lane;
#pragma unroll
      for (int j = 0; j < 8; ++j) w[j] = wr[64 * j]; }
    u32x2 xx[8]; unsigned ya[8], yb[8];
#define FIN_LOAD(m_) do { const GAS u32x2* xr = (const GAS u32x2*)(X1B + (size_t)(m_) * DM) + lane; const GAS unsigned* y0 = (const GAS unsigned*)(Y + (size_t)(m_) * DM) + lane; const GAS unsigned* y1 = (const GAS unsigned*)(Y + ((size_t)T + (m_)) * DM) + lane; \
        _Pragma("unroll") for (int j = 0; j < 8; ++j) { xx[j] = __builtin_nontemporal_load(xr + 64 * j); ya[j] = __builtin_nontemporal_load(y0 + 64 * j); yb[j] = __builtin_nontemporal_load(y1 + 64 * j); } } while (0)
    int m = gw; if (m >= T) return;
    FIN_LOAD(m);
    for (;;) {
        f32x4 v[8]; float s = 0.f;
#pragma unroll
        for (int j = 0; j < 8; ++j) { const f32x4 a = unpk4_fp8(ya[j]), b = unpk4_fp8(yb[j]);
            v[j].x = bf_lo(xx[j].x) + (a.x + b.x) * (1.0f / 16.0f); v[j].y = bf_hi(xx[j].x) + (a.y + b.y) * (1.0f / 16.0f); v[j].z = bf_lo(xx[j].y) + (a.z + b.z) * (1.0f / 16.0f); v[j].w = bf_hi(xx[j].y) + (a.w + b.w) * (1.0f / 16.0f);
            s += (v[j].x * v[j].x + v[j].y * v[j].y) + (v[j].z * v[j].z + v[j].w * v[j].w); }
        const int mn = m + NGW; const bool more = mn < T;
        if (more) FIN_LOAD(mn);
        const float rstd = 1.0f / sqrtf(wave_sum(s) * (1.0f / DM) + RMS_EPS);
        GAS f32x4* o = (GAS f32x4*)(A.out + (size_t)m * DM) + lane;
#pragma unroll
        for (int j = 0; j < 8; ++j) __builtin_nontemporal_store(v[j] * rstd * w[j], o + 64 * j);
        if (!more) break;
        m = mn;
    }
#undef FIN_LOAD
}

constexpr int NPHASE = 10;
__global__ void __launch_bounds__(512, 2) mk_fwd(Args args) {
    extern __shared__ __attribute__((aligned(16))) unsigned char lds_raw[];
    Frame F;
    F.lds = (LAS unsigned char*)lds_raw; F.ldsg = lds_raw; F.ws = args.ws;
    F.tid = threadIdx.x; F.lane = F.tid & 63; F.wave = __builtin_amdgcn_readfirstlane(F.tid >> 6); F.G = gridDim.x; F.bid = blockIdx.x;
    const int lo = args.ph_lo, hi = args.ph_hi;
#define REFRESH() do { F.tid = fresh_tid(); F.lane = F.tid & 63; F.wave = __builtin_amdgcn_readfirstlane(F.tid >> 6); } while (0)
#ifndef MK_PHMASK
#define MK_PHMASK 0x3ff
#endif
#define IN(k) (((MK_PHMASK >> (k)) & 1) && lo <= (k) && (k) < hi)
#if MK_MULTI
#define SEAM(k) do { } while (0)
#else
    { volatile LAS unsigned* mw = (volatile LAS unsigned*)(F.lds + MISC_OFF + 1024); if (F.tid < 16) mw[F.tid] = 0u; __syncthreads(); }
    const XcdBarrier xbar = xcd_barrier_post((unsigned*)(F.ws + WS_CTL) + CW_BAR, (volatile LAS unsigned*)(F.lds + MISC_OFF + 1024));
#define SEAM(k) do { if (IN(k) && IN((k) + 1)) { xcd_barrier(xbar); } } while (0)
#endif
    if (IN(0)) { REFRESH(); p0_prologue(F, args); REFRESH(); p1_tables(F, args, 0); } SEAM(0);
    if (IN(1)) { REFRESH();
        { SchedIn8 S{F.G, F.bid, (const char*)F.ws}; EpiInProj E{F.ws, F.lds}; stage_in_scales(F, S); pg8::gemm_phase<true, false, true>(F.lds, F.ws, 1024, S, E); }
    } SEAM(1);
    if (IN(2)) { REFRESH(); attn_phase(F); retention_phase(F, args);
        if (F.bid >= 208) { REFRESH(); SchedInLate S{F.G - 208, F.bid - 208, (const char*)F.ws}; EpiInProj E{F.ws, F.lds}; stage_in_scales(F, S); pg8::gemm_phase<true, false, true>(F.lds, F.ws, 1024, S, E); }
        REFRESH(); filler_convert(F, args, 0, 1 << 30); } SEAM(2);
    if (IN(3)) { REFRESH();
        { SchedDense S{F.G, F.bid, (const char*)F.ws, (unsigned)WS_OA, (unsigned)WS_WMT, 256u * 1024u}; EpiMixA E{F.ws}; pg8::gemm_phase<true, true, false>(F.lds, F.ws, 512, S, E); }
        VM_WAIT(); __syncthreads();
        { SchedDense S{F.G, F.bid, (const char*)F.ws, (unsigned)WS_YR, (unsigned)WS_WRT2, 256u * 2048u}; EpiMixB E{F.ws}; pg8::gemm_phase<true, true, false>(F.lds, F.ws, 1024, S, E); }
    } SEAM(3);
    if (IN(4)) { REFRESH();
        SchedDense S{F.G, F.bid, (const char*)F.ws, (unsigned)WS_MIX, (unsigned)WS_WOT, 256u * 2048u}; EpiOut E{args.in[I_X], F.ws, false};
        pg8::gemm_phase<true, false, true>(F.lds, F.ws, 1024, S, E);
    } SEAM(4);
    if (IN(5)) { REFRESH(); router_phase(F, args); } SEAM(5);
    if (IN(7)) { REFRESH();
        build_tables(F);
        SchedExpert<true> S{F.G, F.bid, 4, (const char*)F.ws, (unsigned)WS_X1B8, (unsigned)WS_W1T, 256u * 2048u, 256u * 2048u, 4, (const LAS int*)(F.lds + MISC_OFF), (const LAS int*)(F.lds + TOKT_OFF)};
        fill_unit_tokens(F, S);
        EpiExp1 E{F.ws, (const LAS int*)(F.lds + TOKT_OFF), F.lds};
        pg8::gemm_phase<true, false, false>(F.lds, F.ws, 1024, S, E);
        REFRESH(); filler_convert(F, args, 1, 1 << 30);
    } SEAM(7);
    if (IN(8)) { REFRESH();
        if (!IN(7)) build_tables(F);
        SchedExpert<false> S{F.G, F.bid, 8, (const char*)F.ws, (unsigned)WS_ACT, (unsigned)WS_W2T, 256u * 512u, 256u * 512u, 8, (const LAS int*)(F.lds + MISC_OFF), nullptr};
        EpiExp2 E{F.ws, (const LAS int*)(F.lds + MISC_OFF), F.lds};
        pg8::gemm_phase<true, true, false>(F.lds, F.ws, 256, S, E);
    } SEAM(8);
    if (IN(9)) { REFRESH(); final_phase(F, args); }
#undef IN
#undef SEAM
}

extern "C" void kernel_launch(void* const* d_in, const int* in_sizes, int n_in, void* d_out, int out_size, void* d_ws, size_t ws_size, hipStream_t stream) {
    static int grid = 0;
    if (grid == 0) {
        if (n_in != 16 || out_size != T * DM || ws_size < WS_END) { fprintf(stderr, "kernel_launch: unexpected shapes (n_in %d out %d ws %zu)\n", n_in, out_size, ws_size); grid = -1; return; }
        int dev = 0, cus = 0, per_cu = 0;
        (void)hipGetDevice(&dev); (void)hipDeviceGetAttribute(&cus, hipDeviceAttributeMultiprocessorCount, dev);
        (void)hipFuncSetAttribute((const void*)mk_fwd, hipFuncAttributeMaxDynamicSharedMemorySize, LDS_BYTES);
        (void)hipOccupancyMaxActiveBlocksPerMultiprocessor(&per_cu, (const void*)mk_fwd, 512, LDS_BYTES);
        if (per_cu < 1) fprintf(stderr, "kernel_launch: occupancy query says %d blocks/CU\n", per_cu);
        (void)hipGetLastError();
        grid = cus > 0 ? cus : 256;
    }
    if (grid < 0) return;
    (void)hipMemsetAsync((char*)d_ws + WS_CTL, 0, CTL_ZERO_BYTES, stream);
    Args a{};
    for (int i = 0; i < 16; ++i) a.in[i] = (const float*)d_in[i];
    a.out = (float*)d_out; a.ws = (unsigned char*)d_ws;
#if MK_MULTI
    for (int p = 0; p < NPHASE; ++p) { a.ph_lo = p; a.ph_hi = p + 1; hipLaunchKernelGGL(mk_fwd, dim3(grid), dim3(512), LDS_BYTES, stream, a); }
#else
    a.ph_lo = 0; a.ph_hi = NPHASE;
    hipLaunchKernelGGL(mk_fwd, dim3(grid), dim3(512), LDS_BYTES, stream, a);
#endif
}
```
